# Optimizing an MI355X kernel written in HIP

```python
import math
import jax, jax.numpy as jnp
from jax import lax
import numpy as np

D_MODEL = 1024
BATCH = 1
SEQ = 16384
DEPTH = 4

GRID_W = 64
CTX_LEN = 256
EPS = 1e-6
Q_BLOCK = 128
ROPE_BASE = 10000.0

NA_HEADS = 8
NA_HD = 64
NA_W = NA_HEADS * NA_HD
WIN_R = 8
WIN_C = 16

MLA_HEADS = 8
MLA_NOPE = 64
MLA_ROPE = 32
MLA_V = 64
MLA_QK = MLA_NOPE + MLA_ROPE
MLA_W = MLA_HEADS * MLA_V
Q_LORA = 384
KV_LORA = 256

DIFF_HEADS = 4
DIFF_HD = 64
DIFF_W = DIFF_HEADS * 2 * DIFF_HD

LRU_W = 512
LRU_BLOCKS = 8
LRU_BW = LRU_W // LRU_BLOCKS
CONV_W = 4
LRU_C = 8.0

EVEN_SPLITS = (NA_W, NA_W, NA_W, NA_W, Q_LORA, KV_LORA, MLA_ROPE, MLA_W)
EVEN_IN = sum(EVEN_SPLITS)
EVEN_MIX = NA_W + MLA_W
ODD_SPLITS = (DIFF_W, DIFF_W, DIFF_W, DIFF_W, LRU_W, LRU_W)
ODD_IN = sum(ODD_SPLITS)
ODD_MIX = DIFF_W + LRU_W
N_EVEN = (DEPTH + 1) // 2
N_ODD = DEPTH // 2

kernel_name = 'hybrid_na_mla_diff_rglru_prefix_dit'


def _rmsnorm(x, g):
    xf = x.astype(jnp.float32)
    y = xf * lax.rsqrt(jnp.mean(xf * xf, axis=-1, keepdims=True) + EPS)
    return (y * g.astype(jnp.float32)).astype(x.dtype)


def _split(t, sizes):
    bounds = np.cumsum(sizes)[:-1].tolist()
    return jnp.split(t, bounds, axis=-1)


def _heads(t, n_heads):
    b, n, _ = t.shape
    return t.reshape(b, n, n_heads, -1).transpose(0, 2, 1, 3)


def _merge(t):
    b, h, n, d = t.shape
    return t.transpose(0, 2, 1, 3).reshape(b, n, h * d)


def _axial_angles(n_tok, rot_dim):
    t = jnp.arange(n_tok)
    row = (t // GRID_W).astype(jnp.float32)
    col = (t % GRID_W).astype(jnp.float32)
    n_freq = rot_dim // 4
    inv = ROPE_BASE ** (-jnp.arange(n_freq, dtype=jnp.float32) / n_freq)
    ang = jnp.concatenate([row[:, None] * inv, col[:, None] * inv], axis=-1)
    return jnp.cos(ang), jnp.sin(ang)


def _apply_rope(x, rope):
    cos, sin = rope
    half = x.shape[-1] // 2
    x1 = x[..., :half].astype(jnp.float32)
    x2 = x[..., half:].astype(jnp.float32)
    return jnp.concatenate([x1 * cos - x2 * sin, x1 * sin + x2 * cos], axis=-1).astype(x.dtype)


def _sweep(fn, qs):
    b, h, n, _ = qs[0].shape
    nb = n // Q_BLOCK
    blocks = tuple(q.reshape(b, h, nb, Q_BLOCK, q.shape[-1]).transpose(2, 0, 1, 3, 4) for q in qs)
    out = lax.map(fn, blocks)
    return out.transpose(1, 2, 0, 3, 4).reshape(b, h, n, out.shape[-1])


def _softmax_attn(q, k, v, scale):
    def block(qb):
        (qb,) = qb
        s = jnp.einsum('bhqd,bhkd->bhqk', qb, k, preferred_element_type=jnp.float32) * scale
        p = jax.nn.softmax(s, axis=-1).astype(v.dtype)
        return jnp.einsum('bhqk,bhkd->bhqd', p, v)
    return _sweep(block, (q,))


def _diff_attn(q1, q2, k1, k2, v, lam, scale):
    def block(qb):
        a, b = qb
        s1 = jnp.einsum('bhqd,bhkd->bhqk', a, k1, preferred_element_type=jnp.float32) * scale
        s2 = jnp.einsum('bhqd,bhkd->bhqk', b, k2, preferred_element_type=jnp.float32) * scale
        p = jax.nn.softmax(s1, axis=-1) - lam * jax.nn.softmax(s2, axis=-1)
        return jnp.einsum('bhqk,bhkd->bhqd', p.astype(v.dtype), v)
    return _sweep(block, (q1, q2))


def _neighbourhood_attn(q, k, v, k_ctx, v_ctx, rpb, scale):
    b, h, n, d = q.shape
    rows = n // GRID_W
    kr = min(WIN_R, rows)
    kc = min(WIN_C, GRID_W)
    qg = q.reshape(b, h, rows, GRID_W, d)
    kg = k.reshape(b, h, rows, GRID_W, d)
    vg = v.reshape(b, h, rows, GRID_W, d)
    col = jnp.arange(GRID_W)
    c0 = jnp.clip(col - kc // 2, 0, GRID_W - kc)
    col_idx = c0[:, None] + jnp.arange(kc)[None, :]
    col_off = col_idx - col[:, None] + (WIN_C - 1)

    def row_fn(r):
        r0 = jnp.clip(r - kr // 2, 0, rows - kr)
        qr = lax.dynamic_index_in_dim(qg, r, axis=2, keepdims=False)
        k_rows = lax.dynamic_slice_in_dim(kg, r0, kr, axis=2)
        v_rows = lax.dynamic_slice_in_dim(vg, r0, kr, axis=2)
        k_win = k_rows[:, :, :, col_idx]
        v_win = v_rows[:, :, :, col_idx]
        row_off = r0 + jnp.arange(kr) - r + (WIN_R - 1)
        bias = rpb[:, row_off][:, :, col_off]
        s_lat = jnp.einsum('bhwd,bhawjd->bhwaj', qr, k_win, preferred_element_type=jnp.float32) * scale
        s_lat = s_lat + bias.transpose(0, 2, 1, 3).astype(jnp.float32)
        s_ctx = jnp.einsum('bhwd,bhnd->bhwn', qr, k_ctx, preferred_element_type=jnp.float32) * scale
        s = jnp.concatenate([s_lat.reshape(b, h, GRID_W, kr * kc), s_ctx], axis=-1)
        p = jax.nn.softmax(s, axis=-1).astype(v.dtype)
        p_lat = p[..., :kr * kc].reshape(b, h, GRID_W, kr, kc)
        p_ctx = p[..., kr * kc:]
        return (jnp.einsum('bhwaj,bhawjd->bhwd', p_lat, v_win)
                + jnp.einsum('bhwn,bhnd->bhwd', p_ctx, v_ctx))

    out = lax.map(row_fn, jnp.arange(rows))
    return out.transpose(1, 2, 0, 3, 4).reshape(b, h, n, d)


def _mla_q(p_q, q_norm, w_uq, rope):
    b, n, _ = p_q.shape
    q = (_rmsnorm(p_q, q_norm) @ w_uq).reshape(b, n, MLA_HEADS, MLA_QK).transpose(0, 2, 1, 3)
    if rope is None:
        return q
    return jnp.concatenate([q[..., :MLA_NOPE], _apply_rope(q[..., MLA_NOPE:], rope)], axis=-1)


def _mla_kv(p_kv, p_kr, kv_norm, w_ukv, rope):
    b, n, _ = p_kv.shape
    kv = (_rmsnorm(p_kv, kv_norm) @ w_ukv).reshape(b, n, MLA_HEADS, MLA_NOPE + MLA_V).transpose(0, 2, 1, 3)
    k_rope = p_kr[:, None]
    if rope is not None:
        k_rope = _apply_rope(k_rope, rope)
    k = jnp.concatenate([kv[..., :MLA_NOPE], jnp.broadcast_to(k_rope, (b, MLA_HEADS, n, MLA_ROPE))], axis=-1)
    return k, kv[..., MLA_NOPE:]


def _diff_qk(t, rope):
    b, n, _ = t.shape
    th = t.reshape(b, n, DIFF_HEADS, 2, DIFF_HD).transpose(3, 0, 2, 1, 4)
    if rope is not None:
        th = _apply_rope(th, rope)
    return th[0], th[1]


def _diff_out(o, subln, lam_init):
    return _merge(_rmsnorm(o, subln) * (1.0 - lam_init))


def _gated_out(y, g, w_out):
    return (y * jax.nn.silu(g)) @ w_out


def _dwconv(x, w, bias):
    n = x.shape[1]
    left = CONV_W // 2
    xp = jnp.pad(x, ((0, 0), (left, CONV_W - 1 - left), (0, 0)))
    y = bias
    for j in range(CONV_W):
        y = y + xp[:, j:j + n] * w[j]
    return y


def _blockdiag(x, w, bias):
    b, n, c = x.shape
    xb = x.reshape(b, n, LRU_BLOCKS, LRU_BW)
    return jnp.einsum('bngi,gij->bngj', xb, w).reshape(b, n, c) + bias


def _rglru_coeffs(u, lam, wa, ba, wx, bx):
    uf = u.astype(jnp.float32)
    r = jax.nn.sigmoid(_blockdiag(uf, wa.astype(jnp.float32), ba.astype(jnp.float32)))
    i = jax.nn.sigmoid(_blockdiag(uf, wx.astype(jnp.float32), bx.astype(jnp.float32)))
    log_a = -LRU_C * r * jax.nn.softplus(-lam.astype(jnp.float32))
    return jnp.exp(log_a), jnp.sqrt(-jnp.expm1(2.0 * log_a)) * (i * uf)


def _linear_scan(a, bx, h0, reverse):
    if h0 is not None:
        if reverse:
            bx = bx.at[:, -1].add(a[:, -1] * h0)
        else:
            bx = bx.at[:, 0].add(a[:, 0] * h0)

    def comb(e1, e2):
        a1, b1 = e1
        a2, b2 = e2
        return a1 * a2, a2 * b1 + b2

    _, h = lax.associative_scan(comb, (a, bx), axis=1, reverse=reverse)
    return h


def _bi_rglru(u_l, u_c, lam, wa, ba, wx, bx, ctx_out):
    hs_l, hs_c = [], []
    for d, rev in enumerate((False, True)):
        a_c, b_c = _rglru_coeffs(u_c, lam[d], wa[d], ba[d], wx[d], bx[d])
        h_c = _linear_scan(a_c, b_c, None, rev)
        h_end = h_c[:, 0] if rev else h_c[:, -1]
        a_l, b_l = _rglru_coeffs(u_l, lam[d], wa[d], ba[d], wx[d], bx[d])
        hs_l.append(_linear_scan(a_l, b_l, h_end, rev))
        hs_c.append(h_c)
    y_l = (hs_l[0] + hs_l[1]).astype(u_l.dtype)
    if not ctx_out:
        return y_l, None
    return y_l, (hs_c[0] + hs_c[1]).astype(u_c.dtype)


def _even_mixer(hl, hc, w_in, w_out, rpb, q_norm, w_uq, kv_norm, w_ukv, ctx_out):
    pl = _split(hl @ w_in, EVEN_SPLITS)
    pc = _split(hc @ w_in, EVEN_SPLITS)
    rope = _axial_angles(hl.shape[1], MLA_ROPE)
    na_scale = NA_HD ** -0.5
    mla_scale = MLA_QK ** -0.5
    qa_l, ka_l, va_l = [_heads(t, NA_HEADS) for t in pl[:3]]
    ka_c, va_c = [_heads(t, NA_HEADS) for t in pc[1:3]]
    o_na_l = _neighbourhood_attn(qa_l, ka_l, va_l, ka_c, va_c, rpb, na_scale)
    kb_c, vb_c = _mla_kv(pc[5], pc[6], kv_norm, w_ukv, None)
    kb_l, vb_l = _mla_kv(pl[5], pl[6], kv_norm, w_ukv, rope)
    qb_l = _mla_q(pl[4], q_norm, w_uq, rope)
    o_mla_l = _softmax_attn(qb_l, jnp.concatenate([kb_c, kb_l], axis=2),
                            jnp.concatenate([vb_c, vb_l], axis=2), mla_scale)
    y_l = _gated_out(jnp.concatenate([_merge(o_na_l), _merge(o_mla_l)], axis=-1),
                     jnp.concatenate([pl[3], pl[7]], axis=-1), w_out)
    if not ctx_out:
        return y_l, None
    o_na_c = _softmax_attn(_heads(pc[0], NA_HEADS), ka_c, va_c, na_scale)
    o_mla_c = _softmax_attn(_mla_q(pc[4], q_norm, w_uq, None), kb_c, vb_c, mla_scale)
    y_c = _gated_out(jnp.concatenate([_merge(o_na_c), _merge(o_mla_c)], axis=-1),
                     jnp.concatenate([pc[3], pc[7]], axis=-1), w_out)
    return y_l, y_c


def _odd_mixer(hl, hc, w_in, w_out, lq1, lk1, lq2, lk2, subln, conv_w, conv_b,
               lam, wa, ba, wx, bx, lam_init, ctx_out):
    pl = _split(hl @ w_in, ODD_SPLITS)
    pc = _split(hc @ w_in, ODD_SPLITS)
    rope = _axial_angles(hl.shape[1], DIFF_HD)
    scale = DIFF_HD ** -0.5
    f32 = jnp.float32
    lam_d = (jnp.exp(jnp.sum(lq1.astype(f32) * lk1.astype(f32)))
             - jnp.exp(jnp.sum(lq2.astype(f32) * lk2.astype(f32))) + lam_init)
    q1_l, q2_l = _diff_qk(pl[0], rope)
    k1_l, k2_l = _diff_qk(pl[1], rope)
    k1_c, k2_c = _diff_qk(pc[1], None)
    v_l = _heads(pl[2], DIFF_HEADS)
    v_c = _heads(pc[2], DIFF_HEADS)
    o_diff_l = _diff_attn(q1_l, q2_l, jnp.concatenate([k1_c, k1_l], axis=2),
                          jnp.concatenate([k2_c, k2_l], axis=2),
                          jnp.concatenate([v_c, v_l], axis=2), lam_d, scale)
    u_l = _dwconv(pl[4], conv_w, conv_b)
    u_c = _dwconv(pc[4], conv_w, conv_b)
    h_l, h_c = _bi_rglru(u_l, u_c, lam, wa, ba, wx, bx, ctx_out)
    y_l = _gated_out(jnp.concatenate([_diff_out(o_diff_l, subln, lam_init), h_l], axis=-1),
                     jnp.concatenate([pl[3], pl[5]], axis=-1), w_out)
    if not ctx_out:
        return y_l, None
    q1_c, q2_c = _diff_qk(pc[0], None)
    o_diff_c = _diff_attn(q1_c, q2_c, k1_c, k2_c, v_c, lam_d, scale)
    y_c = _gated_out(jnp.concatenate([_diff_out(o_diff_c, subln, lam_init), h_c], axis=-1),
                     jnp.concatenate([pc[3], pc[5]], axis=-1), w_out)
    return y_l, y_c


def setup_inputs(seed: int = 0) -> dict:
    key = jax.random.key(seed)
    keys = jax.random.split(key, 32)

    def nrm(i, shape, s):
        return s * jax.random.normal(keys[i], shape, jnp.float32)

    E, O, D = N_EVEN, N_ODD, D_MODEL
    u = jax.random.uniform(keys[24], (O, 2, LRU_W), jnp.float32, 0.9, 0.999)
    a = u ** (1.0 / LRU_C)
    return {
        'x': nrm(0, (BATCH, SEQ, D), 1.0),
        'c': nrm(1, (BATCH, D), 1.0),
        'ctx': nrm(2, (BATCH, CTX_LEN, D), 1.0),
        'c_ctx': nrm(3, (D,), 1.0),
        'mod_w': nrm(4, (DEPTH, D, 3 * D), 0.5 * D ** -0.5),
        'mod_b': nrm(5, (DEPTH, 3 * D), 0.02),
        'norm_g': 1.0 + nrm(6, (DEPTH, D), 0.01),
        'final_g': 1.0 + nrm(7, (D,), 0.01),
        'e_w_in': nrm(8, (E, D, EVEN_IN), D ** -0.5),
        'e_w_out': nrm(9, (E, EVEN_MIX, D), EVEN_MIX ** -0.5),
        'na_rpb': nrm(10, (E, NA_HEADS, 2 * WIN_R - 1, 2 * WIN_C - 1), 0.1),
        'mla_q_norm': 1.0 + nrm(11, (E, Q_LORA), 0.01),
        'mla_w_uq': nrm(12, (E, Q_LORA, MLA_HEADS * MLA_QK), Q_LORA ** -0.5),
        'mla_kv_norm': 1.0 + nrm(13, (E, KV_LORA), 0.01),
        'mla_w_ukv': nrm(14, (E, KV_LORA, MLA_HEADS * (MLA_NOPE + MLA_V)), KV_LORA ** -0.5),
        'o_w_in': nrm(15, (O, D, ODD_IN), D ** -0.5),
        'o_w_out': nrm(16, (O, ODD_MIX, D), ODD_MIX ** -0.5),
        'diff_lq1': nrm(17, (O, DIFF_HD), 0.1),
        'diff_lk1': nrm(18, (O, DIFF_HD), 0.1),
        'diff_lq2': nrm(19, (O, DIFF_HD), 0.1),
        'diff_lk2': nrm(20, (O, DIFF_HD), 0.1),
        'diff_subln': 1.0 + nrm(21, (O, 2 * DIFF_HD), 0.01),
        'lru_conv_w': nrm(22, (O, CONV_W, LRU_W), CONV_W ** -0.5),
        'lru_conv_b': nrm(23, (O, LRU_W), 0.02),
        'lru_lambda': jnp.log(a) - jnp.log1p(-a),
        'lru_wa': nrm(25, (O, 2, LRU_BLOCKS, LRU_BW, LRU_BW), LRU_BW ** -0.5),
        'lru_ba': nrm(26, (O, 2, LRU_W), 0.02),
        'lru_wx': nrm(27, (O, 2, LRU_BLOCKS, LRU_BW, LRU_BW), LRU_BW ** -0.5),
        'lru_bx': nrm(28, (O, 2, LRU_W), 0.02),
    }


def reference(x, c, ctx, c_ctx, mod_w, mod_b, norm_g, final_g, e_w_in, e_w_out, na_rpb,
              mla_q_norm, mla_w_uq, mla_kv_norm, mla_w_ukv, o_w_in, o_w_out,
              diff_lq1, diff_lk1, diff_lq2, diff_lk2, diff_subln, lru_conv_w, lru_conv_b,
              lru_lambda, lru_wa, lru_ba, lru_wx, lru_bx):
    xl, xc = x, ctx
    s_lat = jax.nn.silu(c)
    s_ctx = jax.nn.silu(c_ctx)
    for l in range(DEPTH):
        ctx_out = l < DEPTH - 1
        i = l // 2
        sh_l, sc_l, g_l = jnp.split(s_lat @ mod_w[l] + mod_b[l], 3, axis=-1)
        sh_c, sc_c, g_c = jnp.split(s_ctx @ mod_w[l] + mod_b[l], 3, axis=-1)
        hl = _rmsnorm(xl, norm_g[l]) * (1.0 + sc_l[:, None]) + sh_l[:, None]
        hc = _rmsnorm(xc, norm_g[l]) * (1.0 + sc_c) + sh_c
        if l % 2 == 0:
            yl, yc = _even_mixer(hl, hc, e_w_in[i], e_w_out[i], na_rpb[i], mla_q_norm[i],
                                 mla_w_uq[i], mla_kv_norm[i], mla_w_ukv[i], ctx_out)
        else:
            lam_init = 0.8 - 0.6 * math.exp(-0.3 * l)
            yl, yc = _odd_mixer(hl, hc, o_w_in[i], o_w_out[i], diff_lq1[i], diff_lk1[i],
                                diff_lq2[i], diff_lk2[i], diff_subln[i], lru_conv_w[i],
                                lru_conv_b[i], lru_lambda[i], lru_wa[i], lru_ba[i],
                                lru_wx[i], lru_bx[i], lam_init, ctx_out)
        xl = xl + g_l[:, None] * yl
        if ctx_out:
            xc = xc + g_c * yc
    return _rmsnorm(xl, final_g)
```

```cpp
#include <hip/hip_runtime.h>
#include <hip/hip_cooperative_groups.h>
#include <cstdio>
namespace cg = cooperative_groups;

#ifndef COOP
#define COOP 1
#endif

#define DI __device__ __forceinline__
typedef unsigned short bf16;
using bf16x8 = __attribute__((ext_vector_type(8))) short;
using f32x16 = __attribute__((ext_vector_type(16))) float;
typedef __bf16 v2bf __attribute__((ext_vector_type(2)));
typedef float v2f __attribute__((ext_vector_type(2)));
typedef unsigned u32x4 __attribute__((ext_vector_type(4)));
typedef unsigned u32x2 __attribute__((ext_vector_type(2)));
#define MFMA(a, b, c) __builtin_amdgcn_mfma_f32_32x32x16_bf16((a), (b), (c), 0, 0, 0)

constexpr int NT = 16640;
constexpr int NCTX = 256;
constexpr int E_IN = 3232, E_INP = 3328, O_IN = 3072;
constexpr float EPS = 1e-6f;
constexpr float LOG2E = 1.4426950408889634f;
constexpr int NCHUNK = 260;

constexpr size_t al(size_t x) { return (x + 255) & ~size_t(255); }
constexpr size_t OFF_XC   = 0;
constexpr size_t OFF_MOD  = OFF_XC + al(256 * 1024 * 4);
constexpr size_t OFF_T64  = OFF_MOD + al(4 * 2 * 3072 * 4);
constexpr size_t OFF_T32  = OFF_T64 + al(256 * 16 * 8);
constexpr size_t OFF_CAR  = OFF_T32 + al(256 * 8 * 8);
constexpr size_t SZ_WEIN  = (size_t)E_INP * 1024 * 2;
constexpr size_t SZ_WOUT  = (size_t)1024 * 1024 * 2;
constexpr size_t SZ_WUQ   = (size_t)768 * 384 * 2;
constexpr size_t SZ_WUKV  = (size_t)1024 * 256 * 2;
constexpr size_t SZ_WOIN  = (size_t)O_IN * 1024 * 2;
constexpr size_t OFF_WEIN = OFF_CAR + al(NCHUNK * 2 * 512 * 8);
constexpr size_t OFF_WEOUT = OFF_WEIN + 2 * SZ_WEIN;
constexpr size_t OFF_WUQ  = OFF_WEOUT + 2 * SZ_WOUT;
constexpr size_t OFF_WUKV = OFF_WUQ + 2 * SZ_WUQ;
constexpr size_t OFF_WOIN = OFF_WUKV + 2 * SZ_WUKV;
constexpr size_t OFF_WOOUT = OFF_WOIN + 2 * SZ_WOIN;
constexpr size_t OFF_HY   = OFF_WOOUT + 2 * SZ_WOUT;
constexpr size_t OFF_G    = OFF_HY + (size_t)NT * 1024 * 2;
constexpr size_t SZ_H64   = (size_t)8 * NT * 64 * 2;
constexpr size_t OFF_QA   = OFF_G + (size_t)NT * 1024 * 2;
constexpr size_t OFF_KA   = OFF_QA + SZ_H64;
constexpr size_t OFF_VAT  = OFF_KA + SZ_H64;
constexpr size_t OFF_QL   = OFF_VAT + SZ_H64;
constexpr size_t OFF_KVL  = OFF_QL + (size_t)NT * 384 * 2;
constexpr size_t OFF_QM   = OFF_KVL + (size_t)NT * 256 * 2;
constexpr size_t OFF_KM   = OFF_QM + (size_t)8 * NT * 96 * 2;
constexpr size_t OFF_VMT  = OFF_KM + (size_t)8 * NT * 96 * 2;
constexpr size_t OFF_BAR  = OFF_VMT + SZ_H64;
constexpr size_t OFF_LW   = OFF_BAR + 2048;
constexpr size_t WS_END   = OFF_LW + (size_t)64 * 4096 * 2;
static_assert(WS_END <= (size_t)256 * 1024 * 1024, "workspace too large");

constexpr int LDS_BYTES = 63 * 1024;

struct Params { const float* in[29]; float* out; unsigned char* ws; };

enum { I_X = 0, I_C, I_CTX, I_CCTX, I_MODW, I_MODB, I_NORMG, I_FINALG, I_EWIN, I_EWOUT, I_RPB, I_QNORM, I_WUQ, I_KVNORM, I_WUKV,
       I_OWIN, I_OWOUT, I_LQ1, I_LK1, I_LQ2, I_LK2, I_SUBLN, I_CONVW, I_CONVB, I_LAMBDA, I_WA, I_BA, I_WX, I_BX };

DI float bf2f(bf16 u) { return __uint_as_float(((unsigned)u) << 16); }
DI unsigned pack2(float a, float b) { v2f x = {a, b}; v2bf r = __builtin_convertvector(x, v2bf); return __builtin_bit_cast(unsigned, r); }
DI bf16 f2bf(float x) { return (bf16)pack2(x, x); }
DI int crow(int i, int h) { return (i & 3) + 8 * (i >> 2) + 4 * h; }
DI float sigm(float x) { return __builtin_amdgcn_rcpf(1.f + __expf(-x)); }
DI float silu(float x) { return x * sigm(x); }
DI float wave_sum(float v) {
#pragma unroll
  for (int o = 32; o > 0; o >>= 1) v += __shfl_xor(v, o);
  return v;
}
DI int launder(int wv) { int l; asm volatile("v_mbcnt_lo_u32_b32 %0, -1, 0\n\tv_mbcnt_hi_u32_b32 %0, -1, %0" : "=v"(l)); return (wv << 6) + l; }
DI float* xrow(const Params& p, int row) {
  return row < NCTX ? (float*)(p.ws + OFF_XC) + (size_t)row * 1024 : p.out + (size_t)(row - NCTX) * 1024;
}

DI const float* xrow_in(const Params& p, int row) {
  return row < NCTX ? p.in[I_CTX] + (size_t)row * 1024 : p.in[I_X] + (size_t)(row - NCTX) * 1024;
}

DI void prep_wtile(const Params& p, unsigned char* smem, int item, int tid) {
  tid = launder(tid);
  int lay = 0, kind = 0, K = 0, N = 0, NP = 0; const float* src = nullptr; const float* gv = nullptr; bf16* dst = nullptr;
  int rem = item;
  const unsigned long long order = 0xBA9875312640ull;
#pragma unroll 1
  for (int q = 0; q < 12; ++q) {
    const int d = (int)((order >> (4 * q)) & 15ull);
    kind = d >> 1; lay = d & 1;
    switch (kind) {
      case 0: K = 1024; N = E_IN; NP = E_INP; break;
      case 1: K = 1024; N = 1024; NP = 1024; break;
      case 2: K = 384; N = 768; NP = 768; break;
      case 3: K = 256; N = 1024; NP = 1024; break;
      case 4: K = 1024; N = O_IN; NP = O_IN; break;
      default: K = 1024; N = 1024; NP = 1024; break;
    }
    int nt = (K >> 6) * (NP >> 6);
    if (rem < nt) break;
    rem -= nt;
  }
  switch (kind) {
    case 0: src = p.in[I_EWIN] + (size_t)lay * 1024 * E_IN; dst = (bf16*)(p.ws + OFF_WEIN + lay * SZ_WEIN); break;
    case 1: src = p.in[I_EWOUT] + (size_t)lay * 1024 * 1024; dst = (bf16*)(p.ws + OFF_WEOUT + lay * SZ_WOUT); break;
    case 2: src = p.in[I_WUQ] + (size_t)lay * 384 * 768; dst = (bf16*)(p.ws + OFF_WUQ + lay * SZ_WUQ); gv = p.in[I_QNORM] + lay * 384; break;
    case 3: src = p.in[I_WUKV] + (size_t)lay * 256 * 1024; dst = (bf16*)(p.ws + OFF_WUKV + lay * SZ_WUKV); gv = p.in[I_KVNORM] + lay * 256; break;
    case 4: src = p.in[I_OWIN] + (size_t)lay * 1024 * O_IN; dst = (bf16*)(p.ws + OFF_WOIN + lay * SZ_WOIN); break;
    default: src = p.in[I_OWOUT] + (size_t)lay * 1024 * 1024; dst = (bf16*)(p.ws + OFF_WOOUT + lay * SZ_WOUT); break;
  }
  const int ktiles = K >> 6;
  const int k0 = (rem % ktiles) * 64, n0 = (rem / ktiles) * 64;
  float* t = (float*)smem;
  __syncthreads();
#pragma unroll
  for (int i = 0; i < 16; ++i) {
    int k = i * 4 + (tid >> 6), n = tid & 63;
    float v = 0.f;
    if (n0 + n < N) { v = src[(size_t)(k0 + k) * N + n0 + n]; if (gv) v *= gv[k0 + k]; }
    t[k * 65 + n] = v;
  }
  __syncthreads();
#pragma unroll
  for (int i = 0; i < 16; ++i) {
    int n = i * 4 + (tid >> 6), k = tid & 63;
    dst[(size_t)(n0 + n) * K + k0 + k] = f2bf(t[k * 65 + n]);
  }
}
constexpr int N_WTILES = 2 * (16 * 52 + 256 + 6 * 12 + 4 * 16 + 16 * 48 + 256);
constexpr int N_WEARLY = 16 * 52 + 6 * 12 + 4 * 16 + 256;

DI void prep_lruw(const Params& p, unsigned char* smem, int item, int tid) {
  tid = launder(tid);
  const int which = item & 1, m = item >> 1;
  const float* src = (which ? p.in[I_WX] : p.in[I_WA]) + (size_t)m * 4096;
  bf16* dst = (bf16*)(p.ws + OFF_LW) + (size_t)item * 4096;
  float* t = (float*)smem;
  __syncthreads();
#pragma unroll
  for (int i = 0; i < 16; ++i) { int k = i * 4 + (tid >> 6), n = tid & 63; t[k * 65 + n] = src[k * 64 + n]; }
  __syncthreads();
#pragma unroll
  for (int i = 0; i < 16; ++i) { int n = i * 4 + (tid >> 6), k = tid & 63; dst[n * 64 + k] = f2bf(t[k * 65 + n]); }
}


DI void prep_mod(const Params& p, unsigned char* smem, int item, int tid) {
  tid = launder(tid);
  const int l = item / 48, cb = item % 48;
  const int col = cb * 64 + (tid & 63), kg = tid >> 6;
  const float* w = p.in[I_MODW] + (size_t)l * 1024 * 3072;
  float* sv = (float*)smem + 512;
  __syncthreads();
#pragma unroll
  for (int i = 0; i < 4; ++i) { int k = tid + 256 * i; sv[k] = silu(p.in[I_C][k]); sv[1024 + k] = silu(p.in[I_CCTX][k]); }
  __syncthreads();
  float aL = 0.f, aC = 0.f;
#pragma unroll 16
  for (int k = kg * 256; k < kg * 256 + 256; ++k) {
    float wv = w[(size_t)k * 3072 + col];
    aL += sv[k] * wv;
    aC += sv[1024 + k] * wv;
  }
  float* t = (float*)smem;
  __syncthreads();
  t[tid] = aL; t[256 + tid] = aC;
  __syncthreads();
  if (tid < 64) {
    float b = p.in[I_MODB][l * 3072 + col];
    float sL = t[tid] + t[64 + tid] + t[128 + tid] + t[192 + tid] + b;
    float sC = t[256 + tid] + t[320 + tid] + t[384 + tid] + t[448 + tid] + b;
    float* mod = (float*)(p.ws + OFF_MOD);
    mod[(l * 2 + 0) * 3072 + col] = sL;
    mod[(l * 2 + 1) * 3072 + col] = sC;
  }
}

DI void prep_tab(const Params& p, int item, int tid) {
  tid = launder(tid);
  int e = item * 256 + tid;
  if (e < 4096) {
    int pos = e >> 4, f = e & 15;
    float inv = powf(10000.f, -(float)f / 16.f);
    float a = (float)pos * inv, s, c; sincosf(a, &s, &c);
    ((float2*)(p.ws + OFF_T64))[e] = make_float2(c, s);
  } else {
    e -= 4096;
    int pos = e >> 3, f = e & 7;
    float inv = powf(10000.f, -(float)f / 8.f);
    float a = (float)pos * inv, s, c; sincosf(a, &s, &c);
    ((float2*)(p.ws + OFF_T32))[e] = make_float2(c, s);
  }
}

DI void prep_copy(const Params& p, int item, int tid) {
  tid = launder(tid);
#pragma unroll 4
  for (int i = 0; i < 16; ++i) {
    int row = item * 16 + i;
    const float* s = row < NCTX ? p.in[I_CTX] + (size_t)row * 1024 : p.in[I_X] + (size_t)(row - NCTX) * 1024;
    ((float4*)xrow(p, row))[tid] = ((const float4*)s)[tid];
  }
}

DI void norm_rows(const Params& p, int l, int item, int tid) {
  tid = launder(tid);
  const int row = item * 4 + (tid >> 6), lane = tid & 63;
  const float* x = (l == 0) ? xrow_in(p, row) : (const float*)xrow(p, row);
  float4 v[4]; float ss = 0.f;
#pragma unroll
  for (int i = 0; i < 4; ++i) { v[i] = ((const float4*)x)[i * 64 + lane]; ss += v[i].x * v[i].x + v[i].y * v[i].y + v[i].z * v[i].z + v[i].w * v[i].w; }
  ss = wave_sum(ss);
  const float rstd = rsqrtf(ss * (1.f / 1024.f) + EPS);
  const float* mod = (const float*)(p.ws + OFF_MOD) + (l * 2 + (row < NCTX ? 1 : 0)) * 3072;
  const float* g = p.in[I_NORMG] + l * 1024;
  bf16* h = (bf16*)(p.ws + OFF_HY) + (size_t)row * 1024;
#pragma unroll
  for (int i = 0; i < 4; ++i) {
    int k = (i * 64 + lane) * 4;
    float4 gg = *(const float4*)(g + k), sh = *(const float4*)(mod + k), sc = *(const float4*)(mod + 1024 + k);
    float a = v[i].x * rstd * gg.x * (1.f + sc.x) + sh.x;
    float b = v[i].y * rstd * gg.y * (1.f + sc.y) + sh.y;
    float c = v[i].z * rstd * gg.z * (1.f + sc.z) + sh.z;
    float d = v[i].w * rstd * gg.w * (1.f + sc.w) + sh.w;
    u32x2 o = {pack2(a, b), pack2(c, d)};
    *(u32x2*)(h + k) = o;
  }
}

DI void final_rows(const Params& p, int item, int tid) {
  tid = launder(tid);
  const int row = item * 4 + (tid >> 6), lane = tid & 63;
  float* x = p.out + (size_t)row * 1024;
  float4 v[4]; float ss = 0.f;
#pragma unroll
  for (int i = 0; i < 4; ++i) { v[i] = ((const float4*)x)[i * 64 + lane]; ss += v[i].x * v[i].x + v[i].y * v[i].y + v[i].z * v[i].z + v[i].w * v[i].w; }
  ss = wave_sum(ss);
  const float rstd = rsqrtf(ss * (1.f / 1024.f) + EPS);
  const float* g = p.in[I_FINALG];
#pragma unroll
  for (int i = 0; i < 4; ++i) {
    int k = (i * 64 + lane) * 4;
    float4 gg = *(const float4*)(g + k);
    float4 o = make_float4(v[i].x * rstd * gg.x, v[i].y * rstd * gg.y, v[i].z * rstd * gg.z, v[i].w * rstd * gg.w);
    *(float4*)(x + k) = o;
  }
}

template <bool TR>
DI void gemm_k(const bf16* __restrict__ A, int lda, const bf16* __restrict__ B, int ldb, int K, unsigned char* smem,
               f32x16 (&acc)[2][2], int tid, int lane, int wm, int wn) {
  const int lr = lane & 31, lh = lane >> 5;
  u32x4 ra[4], rb[4];
#pragma unroll
  for (int i = 0; i < 4; ++i) {
    int c = tid + 256 * i, row = c >> 3, cj = c & 7;
    ra[i] = *(const u32x4*)(A + (size_t)row * lda + cj * 8);
    rb[i] = *(const u32x4*)(B + (size_t)row * ldb + cj * 8);
  }
#pragma unroll 1
  for (int k0 = 0; k0 < K; k0 += 64) {
    __syncthreads();
#pragma unroll
    for (int i = 0; i < 4; ++i) {
      int c = tid + 256 * i, row = c >> 3, cj = c & 7;
      *(u32x4*)(smem + row * 144 + cj * 16) = ra[i];
      *(u32x4*)(smem + 18432 + row * 144 + cj * 16) = rb[i];
    }
    __syncthreads();
    if (k0 + 64 < K) {
#pragma unroll
      for (int i = 0; i < 4; ++i) {
        int c = tid + 256 * i, row = c >> 3, cj = c & 7;
        ra[i] = *(const u32x4*)(A + (size_t)row * lda + k0 + 64 + cj * 8);
        rb[i] = *(const u32x4*)(B + (size_t)row * ldb + k0 + 64 + cj * 8);
      }
    }
#pragma unroll
    for (int ks = 0; ks < 4; ++ks) {
      bf16x8 af[2], bfr[2];
#pragma unroll
      for (int t = 0; t < 2; ++t) {
        af[t] = *(const bf16x8*)(smem + (wm * 64 + t * 32 + lr) * 144 + ks * 32 + lh * 16);
        bfr[t] = *(const bf16x8*)(smem + 18432 + (wn * 64 + t * 32 + lr) * 144 + ks * 32 + lh * 16);
      }
#pragma unroll
      for (int mt = 0; mt < 2; ++mt)
#pragma unroll
        for (int nt = 0; nt < 2; ++nt)
          acc[mt][nt] = TR ? MFMA(bfr[nt], af[mt], acc[mt][nt]) : MFMA(af[mt], bfr[nt], acc[mt][nt]);
    }
  }
}

enum { EP_EVEN_IN = 0, EP_UPQ, EP_UPKV, EP_ODD_IN, EP_OUT };

DI void st_tile_rm(bf16* base, size_t row_stride, int m0, int lh, const f32x16& a, float s0 = 1.f) {
#pragma unroll
  for (int i = 0; i < 16; ++i) base[(size_t)(m0 + crow(i, lh)) * row_stride] = f2bf(a[i] * s0);
}

DI void stage_val(unsigned char* wl, int row, int col, float v) { *(bf16*)(wl + row * 144 + col * 2) = f2bf(v); }
DI void flush_unit(const unsigned char* wl, int nt, int lane, bf16* base, int stride) {
#pragma unroll
  for (int j = 0; j < 4; ++j) {
    const int c = lane + 64 * j, row = c >> 2, ch = c & 3;
    const u32x4 d = *(const u32x4*)(wl + row * 144 + nt * 64 + ch * 16);
    *(u32x4*)(base + (size_t)row * stride + ch * 8) = d;
  }
}

template <int MODE>
DI void gemm_tile(const Params& p, unsigned char* smem, int layer, int mtile, int ntile, int tid) {
  tid = launder(tid);
  const int li = layer >> 1;
  const int lane = tid & 63, lr = lane & 31, lh = lane >> 5;
  const int wave = __builtin_amdgcn_readfirstlane(tid >> 6);
  const int wm = wave >> 1, wn = wave & 1;
  const int m0 = mtile * 128, n0 = ntile * 128;
  const int m0w = m0 + wm * 64, n0w = n0 + wn * 64;
  const bool is_lat = m0 >= NCTX;
  unsigned char* ws = p.ws;
  const bf16* A; const bf16* B; int lda, K;
  bool tr = false;
  if (MODE == EP_EVEN_IN) { A = (const bf16*)(ws + OFF_HY); lda = 1024; K = 1024; B = (const bf16*)(ws + OFF_WEIN + li * SZ_WEIN); tr = (n0w >= 1024 && n0w < 1536); }
  else if (MODE == EP_ODD_IN) { A = (const bf16*)(ws + OFF_HY); lda = 1024; K = 1024; B = (const bf16*)(ws + OFF_WOIN + li * SZ_WOIN); tr = (n0w >= 1024 && n0w < 1536); }
  else if (MODE == EP_UPQ) { A = (const bf16*)(ws + OFF_QL); lda = 384; K = 384; B = (const bf16*)(ws + OFF_WUQ + li * SZ_WUQ); }
  else if (MODE == EP_UPKV) { A = (const bf16*)(ws + OFF_KVL); lda = 256; K = 256; B = (const bf16*)(ws + OFF_WUKV + li * SZ_WUKV); tr = ((n0w >> 6) & 1) != 0; }
  else { A = (const bf16*)(ws + OFF_HY); lda = 1024; K = 1024; B = (const bf16*)(ws + ((layer & 1) ? OFF_WOOUT : OFF_WEOUT) + li * SZ_WOUT); }
  A += (size_t)m0 * lda; B += (size_t)n0 * K;

  float* rs = (float*)(smem + 36864);
  if (MODE == EP_UPQ || MODE == EP_UPKV) {
    __syncthreads();
    const int row = tid >> 1, half = tid & 1, hk = K >> 1;
    const bf16* ar = A + (size_t)row * lda + half * hk;
    float ss = 0.f;
    for (int k = 0; k < hk; k += 8) {
      u32x4 u = *(const u32x4*)(ar + k);
      unsigned w4[4] = {u.x, u.y, u.z, u.w};
#pragma unroll
      for (int j = 0; j < 4; ++j) { float a = __uint_as_float(w4[j] << 16), b = __uint_as_float(w4[j] & 0xffff0000u); ss += a * a + b * b; }
    }
    ss += __shfl_xor(ss, 1);
    if (half == 0) rs[row] = rsqrtf(ss / (float)K + EPS);
  }

  f32x16 acc[2][2];
#pragma unroll
  for (int a = 0; a < 2; ++a)
#pragma unroll
    for (int b = 0; b < 2; ++b)
#pragma unroll
      for (int i = 0; i < 16; ++i) acc[a][b][i] = 0.f;
  if (tr) gemm_k<true>(A, lda, B, K, K, smem, acc, tid, lane, wm, wn);
  else gemm_k<false>(A, lda, B, K, K, smem, acc, tid, lane, wm, wn);
  if (MODE == EP_EVEN_IN || MODE == EP_ODD_IN) __syncthreads();
  unsigned char* wl = smem + wave * 9216;

  if (MODE == EP_OUT) {
    const float* gm = (const float*)(ws + OFF_MOD) + (layer * 2 + (is_lat ? 0 : 1)) * 3072 + 2048;
#pragma unroll
    for (int mt = 0; mt < 2; ++mt)
#pragma unroll
      for (int nt = 0; nt < 2; ++nt) {
        const int n = n0w + nt * 32 + lr; const float g = gm[n];
#pragma unroll
        for (int i = 0; i < 16; ++i) {
          const int m = m0w + mt * 32 + crow(i, lh);
          float* x = xrow(p, m) + n;
          const float xin = (layer == 0) ? xrow_in(p, m)[n] : *x;
          *x = xin + g * acc[mt][nt][i];
        }
      }
    return;
  }
  if (MODE == EP_UPQ) {
    const float2* t32 = (const float2*)(ws + OFF_T32);
#pragma unroll
    for (int mt = 0; mt < 2; ++mt)
#pragma unroll
      for (int nt = 0; nt < 2; ++nt) {
        const int nn = n0w + nt * 32, head = nn / 96, j0 = nn % 96;
        bf16* dst = (bf16*)(ws + OFF_QM) + (size_t)head * NT * 96 + j0 + lr;
        const bool rope = (j0 == 64) && is_lat;
#pragma unroll
        for (int i = 0; i < 16; ++i) {
          const int ml = wm * 64 + mt * 32 + crow(i, lh), m = m0 + ml;
          float v = acc[mt][nt][i] * rs[ml];
          if (rope) {
            float pv = __shfl_xor(v, 16);
            int t = m - NCTX, idx = lr & 15, pos = (idx < 8) ? (t >> 6) : (t & 63);
            float2 cs = t32[pos * 8 + (idx & 7)];
            v = (lr < 16) ? (v * cs.x - pv * cs.y) : (pv * cs.y + v * cs.x);
          }
          dst[(size_t)m * 96] = f2bf(v);
        }
      }
    return;
  }
  if (MODE == EP_UPKV) {
    const int head = n0w >> 7;
    if (!tr) {
#pragma unroll
      for (int mt = 0; mt < 2; ++mt)
#pragma unroll
        for (int nt = 0; nt < 2; ++nt) {
          bf16* dst = (bf16*)(ws + OFF_KM) + (size_t)head * NT * 96 + nt * 32 + lr;
#pragma unroll
          for (int i = 0; i < 16; ++i) { const int ml = wm * 64 + mt * 32 + crow(i, lh); dst[(size_t)(m0 + ml) * 96] = f2bf(acc[mt][nt][i] * rs[ml]); }
        }
    } else {
#pragma unroll
      for (int mt = 0; mt < 2; ++mt)
#pragma unroll
        for (int nt = 0; nt < 2; ++nt) {
          const int ml = wm * 64 + mt * 32 + lr; const float r = rs[ml];
          bf16* dst = (bf16*)(ws + OFF_VMT) + (size_t)head * 64 * NT + m0 + ml;
#pragma unroll
          for (int i = 0; i < 16; ++i) dst[(size_t)(nt * 32 + crow(i, lh)) * NT] = f2bf(acc[mt][nt][i] * r);
        }
    }
    return;
  }
  if (MODE == EP_EVEN_IN) {
    if (tr) {
#pragma unroll
      for (int mt = 0; mt < 2; ++mt)
#pragma unroll
        for (int nt = 0; nt < 2; ++nt) {
          const int nb = n0w - 1024 + nt * 32, m = m0w + mt * 32 + lr;
          bf16* dst = (bf16*)(ws + OFF_VAT) + (size_t)nb * NT + m;
#pragma unroll
          for (int i = 0; i < 16; ++i) dst[(size_t)crow(i, lh) * NT] = f2bf(acc[mt][nt][i]);
        }
      return;
    }
    const float2* t32 = (const float2*)(ws + OFF_T32);
#pragma unroll
    for (int mt = 0; mt < 2; ++mt)
#pragma unroll
      for (int nt = 0; nt < 2; ++nt) {
        const int nn = n0w + nt * 32;
        const bool krope = (nn >= 2688 && nn < 2720);
#pragma unroll
        for (int i = 0; i < 16; ++i) {
          const int ml = mt * 32 + crow(i, lh), m = m0w + ml;
          float v = acc[mt][nt][i];
          if (krope && is_lat) {
            float pv = __shfl_xor(v, 16);
            int t = m - NCTX, idx = lr & 15, pos = (idx < 8) ? (t >> 6) : (t & 63);
            float2 cs = t32[pos * 8 + (idx & 7)];
            v = (lr < 16) ? (v * cs.x - pv * cs.y) : (pv * cs.y + v * cs.x);
          }
          stage_val(wl, ml, nt * 32 + lr, v);
        }
      }
#pragma unroll
    for (int nt = 0; nt < 2; ++nt) {
      const int nn = n0w + nt * 32;
      bf16* base = nullptr; int stride = 0;
      if (nn < 512) { base = (bf16*)(ws + OFF_QA) + (size_t)(nn >> 6) * NT * 64 + (nn & 63); stride = 64; }
      else if (nn < 1024) { base = (bf16*)(ws + OFF_KA) + (size_t)((nn - 512) >> 6) * NT * 64 + (nn & 63); stride = 64; }
      else if (nn < 2048) { base = (bf16*)(ws + OFF_G) + (nn - 1536); stride = 1024; }
      else if (nn < 2432) { base = (bf16*)(ws + OFF_QL) + (nn - 2048); stride = 384; }
      else if (nn < 2688) { base = (bf16*)(ws + OFF_KVL) + (nn - 2432); stride = 256; }
      else if (nn < 2720) { base = (bf16*)(ws + OFF_KM) + 64; stride = 96; }
      else if (nn < E_IN) { base = (bf16*)(ws + OFF_G) + 512 + (nn - 2720); stride = 1024; }
      if (!base) continue;
      base += (size_t)m0w * stride;
      flush_unit(wl, nt, lane, base, stride);
      if (nn >= 2688 && nn < 2720) {
#pragma unroll 1
        for (int hh = 1; hh < 8; ++hh) flush_unit(wl, nt, lane, base + (size_t)hh * NT * 96, stride);
      }
    }
    return;
  }
  if (MODE == EP_ODD_IN) {
    if (tr) {
#pragma unroll
      for (int mt = 0; mt < 2; ++mt)
#pragma unroll
        for (int nt = 0; nt < 2; ++nt) {
          const int nb = n0w - 1024 + nt * 32, m = m0w + mt * 32 + lr;
          bf16* dst = (bf16*)(ws + OFF_VAT) + (size_t)nb * NT + m;
#pragma unroll
          for (int i = 0; i < 16; ++i) dst[(size_t)crow(i, lh) * NT] = f2bf(acc[mt][nt][i]);
        }
      return;
    }
    if (n0w < 1024) {
      const float2* t64 = (const float2*)(ws + OFF_T64);
      const int hw = (n0w & 511) >> 6;
      bf16* base = (bf16*)(ws + (n0w < 512 ? OFF_QA : OFF_KA)) + (size_t)hw * NT * 64;
#pragma unroll
      for (int mt = 0; mt < 2; ++mt) {
#pragma unroll
        for (int i = 0; i < 16; ++i) {
          const int m = m0w + mt * 32 + crow(i, lh);
          float x1 = acc[mt][0][i], x2 = acc[mt][1][i];
          if (is_lat) {
            int t = m - NCTX, pos = (lr < 16) ? (t >> 6) : (t & 63);
            float2 cs = t64[pos * 16 + (lr & 15)];
            float y1 = x1 * cs.x - x2 * cs.y, y2 = x1 * cs.y + x2 * cs.x;
            x1 = y1; x2 = y2;
          }
          stage_val(wl, mt * 32 + crow(i, lh), lr, x1);
          stage_val(wl, mt * 32 + crow(i, lh), 32 + lr, x2);
        }
      }
      flush_unit(wl, 0, lane, base + (size_t)m0w * 64, 64);
      flush_unit(wl, 1, lane, base + (size_t)m0w * 64 + 32, 64);
      return;
    }
#pragma unroll
    for (int mt = 0; mt < 2; ++mt)
#pragma unroll
      for (int nt = 0; nt < 2; ++nt) {
#pragma unroll
        for (int i = 0; i < 16; ++i) stage_val(wl, mt * 32 + crow(i, lh), nt * 32 + lr, acc[mt][nt][i]);
      }
#pragma unroll
    for (int nt = 0; nt < 2; ++nt) {
      const int nn = n0w + nt * 32;
      bf16* base; int stride;
      if (nn < 2048) { base = (bf16*)(ws + OFF_G) + (nn - 1536); stride = 1024; }
      else if (nn < 2560) { base = (bf16*)(ws + OFF_QL) + (nn - 2048); stride = 512; }
      else { base = (bf16*)(ws + OFF_G) + 512 + (nn - 2560); stride = 1024; }
      flush_unit(wl, nt, lane, base + (size_t)m0w * stride, stride);
    }
    return;
  }
}

DI float xmax32(float x) { auto r = __builtin_amdgcn_permlane32_swap(__float_as_uint(x), __float_as_uint(x), false, false); return fmaxf(__uint_as_float(r[0]), __uint_as_float(r[1])); }
DI float xsum32(float x) { auto r = __builtin_amdgcn_permlane32_swap(__float_as_uint(x), __float_as_uint(x), false, false); return __uint_as_float(r[0]) + __uint_as_float(r[1]); }
template <int DQK, int DV, int NS, int MODE, int NQ>
DI void attn_item(const Params& p, unsigned char* smem, int layer, int qb, int head, int tid) {
  tid = launder(tid);
  constexpr int KS = DQK * 2 + 16;
  constexpr int VS = 136;
  constexpr int KCH = DQK / 8;
  constexpr int NKC = 64 * KCH / 256;
  constexpr int NVC = DV * 8 / 256;
  constexpr int NDT = DV / 32;
  constexpr int NKS = DQK / 16;
  constexpr int K_BYTES = 64 * KS;
  unsigned char* ws = p.ws;
  const int li = layer >> 1;
  const int lane = tid & 63, lr = lane & 31, lh = lane >> 5;
  const int wave = __builtin_amdgcn_readfirstlane(tid >> 6);
  const bool qctx = qb < 2;

  const bf16* Qp[NS]; const bf16* Kp[NS]; const bf16* VT;
  float c;
  if (MODE == 0) { Qp[0] = (const bf16*)(ws + OFF_QM) + (size_t)head * NT * 96; Kp[0] = (const bf16*)(ws + OFF_KM) + (size_t)head * NT * 96;
                   VT = (const bf16*)(ws + OFF_VMT) + (size_t)head * 64 * NT; c = 0.10206207261596577f * LOG2E; }
  else if (MODE == 1) { Qp[0] = (const bf16*)(ws + OFF_QA) + (size_t)head * NT * 64; Kp[0] = (const bf16*)(ws + OFF_KA) + (size_t)head * NT * 64;
                   VT = (const bf16*)(ws + OFF_VAT) + (size_t)head * 64 * NT; c = 0.125f * LOG2E; }
  else {
#pragma unroll
    for (int s = 0; s < NS; ++s) { Qp[s] = (const bf16*)(ws + OFF_QA) + (size_t)(head * 2 + s) * NT * 64; Kp[s] = (const bf16*)(ws + OFF_KA) + (size_t)(head * 2 + s) * NT * 64; }
    VT = (const bf16*)(ws + OFF_VAT) + (size_t)head * 128 * NT; c = 0.125f * LOG2E;
  }

  int ntiles, kr_lo = 0, r_w = 0, r0w = 0, qc = 0, c0 = 0;
  if (qctx) ntiles = 4;
  else if (MODE == 1) {
    const int lb = qb - 2, ra_ = 2 * lb, rb_ = 2 * lb + 1;
    int r0a = min(max(ra_ - 4, 0), 248), r0b = min(max(rb_ - 4, 0), 248);
    kr_lo = r0a; ntiles = 4 + (r0b + 8 - r0a);
    r_w = 2 * lb + (wave >> 1); r0w = min(max(r_w - 4, 0), 248);
    qc = (wave & 1) * 32 + lr; c0 = min(max(qc - 8, 0), 48);
  } else ntiles = NT / 64;

  float* rpb = (float*)(smem + NS * K_BYTES + DV * VS);
  if (MODE == 1) {
    __syncthreads();
    const float* src = p.in[I_RPB] + (size_t)(li * 8 + head) * 465;
    for (int i = tid; i < 465; i += 256) rpb[i] = src[i] * LOG2E;
  }

  int tq[NQ];
#pragma unroll
  for (int n = 0; n < NQ; ++n) tq[n] = (qb + n) * 128 + wave * 32 + lr;
  bf16x8 qf[NQ][NS][NKS];
#pragma unroll
  for (int n = 0; n < NQ; ++n)
#pragma unroll
    for (int s = 0; s < NS; ++s)
#pragma unroll
      for (int ks = 0; ks < NKS; ++ks) qf[n][s][ks] = *(const bf16x8*)(Qp[s] + (size_t)tq[n] * DQK + ks * 16 + lh * 8);

  f32x16 O[NQ][NS][NDT];
#pragma unroll
  for (int n = 0; n < NQ; ++n)
#pragma unroll
    for (int s = 0; s < NS; ++s)
#pragma unroll
      for (int d = 0; d < NDT; ++d)
#pragma unroll
        for (int i = 0; i < 16; ++i) O[n][s][d][i] = 0.f;
  float mrun[NQ][NS], lrun[NQ][NS];
#pragma unroll
  for (int n = 0; n < NQ; ++n)
#pragma unroll
    for (int s = 0; s < NS; ++s) { mrun[n][s] = -1e30f; lrun[n][s] = 0.f; }

  constexpr bool PF = (MODE != 2);
  u32x4 rk[NS][NKC], rv[NVC];
  auto tile_tok = [&](int it) -> int { return (MODE == 1 && !qctx && it >= 4) ? (NCTX + (kr_lo + it - 4) * 64) : it * 64; };
  auto gload = [&](int it) {
    const int t0 = tile_tok(it);
#pragma unroll
    for (int s = 0; s < NS; ++s)
#pragma unroll
      for (int i = 0; i < NKC; ++i) { int cidx = tid + 256 * i, row = cidx / KCH, cj = cidx % KCH; rk[s][i] = *(const u32x4*)(Kp[s] + (size_t)(t0 + row) * DQK + cj * 8); }
#pragma unroll
    for (int i = 0; i < NVC; ++i) { int cidx = tid + 256 * i, row = cidx >> 3, cj = cidx & 7; rv[i] = *(const u32x4*)(VT + (size_t)row * NT + t0 + cj * 8); }
  };
  if (PF) gload(0);

#pragma unroll 1
  for (int it = 0; it < ntiles; ++it) {
    __syncthreads();
    if (!PF) gload(it);
#pragma unroll
    for (int s = 0; s < NS; ++s)
#pragma unroll
      for (int i = 0; i < NKC; ++i) { int cidx = tid + 256 * i, row = cidx / KCH, cj = cidx % KCH; *(u32x4*)(smem + s * K_BYTES + row * KS + cj * 16) = rk[s][i]; }
#pragma unroll
    for (int i = 0; i < NVC; ++i) { int cidx = tid + 256 * i, row = cidx >> 3, cj = cidx & 7;
      u32x2* d = (u32x2*)(smem + NS * K_BYTES + row * VS + cj * 16); u32x2 d0 = {rv[i].x, rv[i].y}, d1 = {rv[i].z, rv[i].w}; d[0] = d0; d[1] = d1; }
    __syncthreads();
    if (PF && it + 1 < ntiles) gload(it + 1);

    bool active = true; int kr = 0;
    if (MODE == 1 && !qctx && it >= 4) { kr = kr_lo + it - 4; active = (kr >= r0w) && (kr < r0w + 8); }
    if (!active) continue;

#pragma unroll(MODE == 2 ? 1 : 2)
    for (int sub = 0; sub < 2; ++sub) {
      bf16x8 P[NQ][NS][2];
#pragma unroll
      for (int s = 0; s < NS; ++s) {
        f32x16 S[NQ];
#pragma unroll
        for (int n = 0; n < NQ; ++n)
#pragma unroll
          for (int i = 0; i < 16; ++i) S[n][i] = 0.f;
#pragma unroll
        for (int ks = 0; ks < NKS; ++ks) {
          bf16x8 kf = *(const bf16x8*)(smem + s * K_BYTES + (sub * 32 + lr) * KS + ks * 32 + lh * 16);
#pragma unroll
          for (int n = 0; n < NQ; ++n) S[n] = MFMA(kf, qf[n][s][ks], S[n]);
        }
#pragma unroll
        for (int n = 0; n < NQ; ++n) {
          float cc = c;
          if (MODE == 1) {
            cc = 1.f;
            if (!qctx && it >= 4) {
              const float* brow = rpb + (kr - r_w + 7) * 31;
#pragma unroll
              for (int i = 0; i < 16; ++i) {
                const int kc = sub * 32 + crow(i, lh);
                const bool valid = (kc >= c0) && (kc < c0 + 16);
                const int bi = min(max(kc - qc + 15, 0), 30);
                S[n][i] = valid ? (S[n][i] * c + brow[bi]) : -1e30f;
              }
            } else {
#pragma unroll
              for (int i = 0; i < 16; ++i) S[n][i] = S[n][i] * c;
            }
          }
          float mx = S[n][0];
#pragma unroll
          for (int i = 1; i < 16; ++i) mx = fmaxf(mx, S[n][i]);
          mx = xmax32(mx);
          const float mnew = fmaxf(mrun[n][s], mx);
          if (__any(mnew > mrun[n][s])) {
            const float alpha = __builtin_amdgcn_exp2f((mrun[n][s] - mnew) * cc);
            lrun[n][s] *= alpha;
#pragma unroll
            for (int d = 0; d < NDT; ++d)
#pragma unroll
              for (int i = 0; i < 16; ++i) O[n][s][d][i] *= alpha;
            mrun[n][s] = mnew;
          }
          const float mc = mrun[n][s] * cc;
          float ls0 = 0.f, ls1 = 0.f;
#pragma unroll
          for (int i = 0; i < 16; i += 2) { S[n][i] = __builtin_amdgcn_exp2f(S[n][i] * cc - mc); S[n][i + 1] = __builtin_amdgcn_exp2f(S[n][i + 1] * cc - mc); ls0 += S[n][i]; ls1 += S[n][i + 1]; }
          lrun[n][s] += ls0 + ls1;
#pragma unroll
          for (int s2 = 0; s2 < 2; ++s2) {
            u32x4 u = {pack2(S[n][8 * s2 + 0], S[n][8 * s2 + 1]), pack2(S[n][8 * s2 + 2], S[n][8 * s2 + 3]),
                       pack2(S[n][8 * s2 + 4], S[n][8 * s2 + 5]), pack2(S[n][8 * s2 + 6], S[n][8 * s2 + 7])};
            P[n][s][s2] = __builtin_bit_cast(bf16x8, u);
          }
        }
      }
#pragma unroll
      for (int d = 0; d < NDT; ++d)
#pragma unroll
        for (int s2 = 0; s2 < 2; ++s2) {
          const unsigned char* vp = smem + NS * K_BYTES + (d * 32 + lr) * VS + (sub * 32 + 16 * s2 + 4 * lh) * 2;
          u32x2 lo = *(const u32x2*)vp, hi = *(const u32x2*)(vp + 16);
          u32x4 u = {lo.x, lo.y, hi.x, hi.y};
          bf16x8 vf = __builtin_bit_cast(bf16x8, u);
#pragma unroll
          for (int n = 0; n < NQ; ++n)
#pragma unroll
            for (int s = 0; s < NS; ++s) O[n][s][d] = MFMA(vf, P[n][s][s2], O[n][s][d]);
        }
    }
  }

#pragma unroll
  for (int n = 0; n < NQ; ++n) {
    float inv[NS];
#pragma unroll
    for (int s = 0; s < NS; ++s) inv[s] = 1.f / xsum32(lrun[n][s]);
    bf16* yrow = (bf16*)(ws + OFF_HY) + (size_t)tq[n] * 1024;
    const bf16* grow = (const bf16*)(ws + OFF_G) + (size_t)tq[n] * 1024;
    if (MODE != 2) {
      const int col0 = (MODE == 0 ? 512 : 0) + head * 64;
#pragma unroll
      for (int d = 0; d < NDT; ++d)
#pragma unroll
        for (int g4 = 0; g4 < 4; ++g4) {
          const int col = col0 + d * 32 + 8 * g4 + 4 * lh;
          u32x2 gu = *(const u32x2*)(grow + col);
          float g0 = __uint_as_float(gu.x << 16), g1 = __uint_as_float(gu.x & 0xffff0000u), g2 = __uint_as_float(gu.y << 16), g3 = __uint_as_float(gu.y & 0xffff0000u);
          float y0 = O[n][0][d][4 * g4 + 0] * inv[0] * silu(g0), y1 = O[n][0][d][4 * g4 + 1] * inv[0] * silu(g1);
          float y2 = O[n][0][d][4 * g4 + 2] * inv[0] * silu(g2), y3 = O[n][0][d][4 * g4 + 3] * inv[0] * silu(g3);
          { u32x2 yo = {pack2(y0, y1), pack2(y2, y3)}; *(u32x2*)(yrow + col) = yo; }
        }
    } else {
      const float lam_init = __uint_as_float((unsigned)__builtin_amdgcn_readfirstlane((layer == 1) ? 0x3eb60549 : 0x3f0e59d5));
      float v1 = p.in[I_LQ1][li * 64 + lane] * p.in[I_LK1][li * 64 + lane];
      float v2 = p.in[I_LQ2][li * 64 + lane] * p.in[I_LK2][li * 64 + lane];
      v1 = wave_sum(v1); v2 = wave_sum(v2);
      const float lam = __expf(v1) - __expf(v2) + lam_init;
      float ss = 0.f;
#pragma unroll
      for (int d = 0; d < NDT; ++d)
#pragma unroll
        for (int i = 0; i < 16; ++i) { float o = O[n][0][d][i] * inv[0] - lam * (O[n][NS - 1][d][i] * inv[NS - 1]); O[n][0][d][i] = o; ss += o * o; }
      ss = xsum32(ss);
      const float rstd = rsqrtf(ss * (1.f / 128.f) + EPS) * (1.f - lam_init);
      const float* sub = p.in[I_SUBLN] + li * 128;
      const int col0 = head * 128;
#pragma unroll
      for (int d = 0; d < NDT; ++d)
#pragma unroll
        for (int g4 = 0; g4 < 4; ++g4) {
          const int dd = d * 32 + 8 * g4 + 4 * lh, col = col0 + dd;
          u32x2 gu = *(const u32x2*)(grow + col);
          float g0 = __uint_as_float(gu.x << 16), g1 = __uint_as_float(gu.x & 0xffff0000u), g2 = __uint_as_float(gu.y << 16), g3 = __uint_as_float(gu.y & 0xffff0000u);
          float4 sl = *(const float4*)(sub + dd);
          float y0 = O[n][0][d][4 * g4 + 0] * rstd * sl.x * silu(g0), y1 = O[n][0][d][4 * g4 + 1] * rstd * sl.y * silu(g1);
          float y2 = O[n][0][d][4 * g4 + 2] * rstd * sl.z * silu(g2), y3 = O[n][0][d][4 * g4 + 3] * rstd * sl.w * silu(g3);
          { u32x2 yo = {pack2(y0, y1), pack2(y2, y3)}; *(u32x2*)(yrow + col) = yo; }
        }
    }
  }
}

template <bool PASS2>
DI void lru_item(const Params& p, unsigned char* smem, int layer, int chunk, int g, int tid) {
  tid = launder(tid);
  const int oi = layer >> 1;
  unsigned char* ws = p.ws;
  float* us = (float*)smem;
  unsigned char* ubf = smem + 16384;
  float2* ab = (float2*)(smem + 25600);
  float2* seg = (float2*)(smem + 58368);
  float2* seg2 = seg + 256;
  const int j = tid & 63, tg = tid >> 6, ch = g * 64 + j;
  const int t0 = chunk * 64;
  const int seq_lo = chunk < 4 ? 0 : NCTX, seq_hi = chunk < 4 ? NCTX : NT;
  const bf16* lx = (const bf16*)(ws + OFF_QL);
  __syncthreads();
  if (PASS2) {
    const float2* carp = (const float2*)(ws + OFF_CAR);
#pragma unroll
    for (int d = 0; d < 2; ++d) {
      const int npre = (d == 0) ? chunk : (chunk < 4 ? 3 - chunk : 4 + (NCHUNK - 1 - chunk));
      const int i0 = (npre * tg) >> 2, i1 = (npre * (tg + 1)) >> 2;
      float2 cv[65];
#pragma unroll
      for (int q = 0; q < 65; ++q) {
        const int idx = i0 + q;
        const int cc = (d == 0) ? idx : (idx < 4 ? 3 - idx : NCHUNK + 3 - idx);
        cv[q] = make_float2(1.f, 0.f);
        if (idx < i1) cv[q] = carp[(size_t)(cc * 2 + d) * 512 + ch];
      }
      float A = 1.f, B = 0.f;
#pragma unroll
      for (int q = 0; q < 65; ++q) { B = cv[q].x * B + cv[q].y; A *= cv[q].x; }
      seg2[(d * 4 + tg) * 64 + j] = make_float2(A, B);
    }
  }
  {
    const float* cw = p.in[I_CONVW] + (size_t)oi * 4 * 512;
    const float w0 = cw[ch], w1 = cw[512 + ch], w2 = cw[1024 + ch], w3 = cw[1536 + ch], cb = p.in[I_CONVB][oi * 512 + ch];
    float xv[19];
#pragma unroll
    for (int i = 0; i < 19; ++i) { int t = t0 + tg * 16 - 2 + i; xv[i] = (t >= seq_lo && t < seq_hi) ? bf2f(lx[(size_t)t * 512 + ch]) : 0.f; }
#pragma unroll
    for (int tt = 0; tt < 16; ++tt) {
      const float uv = cb + xv[tt] * w0 + xv[tt + 1] * w1 + xv[tt + 2] * w2 + xv[tt + 3] * w3;
      us[(tg * 16 + tt) * 64 + j] = uv;
      *(bf16*)(ubf + (tg * 16 + tt) * 144 + j * 2) = f2bf(uv);
    }
  }
  const int wave_g = __builtin_amdgcn_readfirstlane(tid >> 6);
  const int lane_g = tid & 63, lr_g = lane_g & 31, lh_g = lane_g >> 5;
  const int mt_g = wave_g >> 1, nt_g = wave_g & 1;
  const int cj_g = nt_g * 32 + lr_g, chj_g = g * 64 + cj_g;
  bf16x8 wfa[2][4], wfx[2][4];
  float pba[2], pbx[2], plam[2];
#pragma unroll
  for (int d = 0; d < 2; ++d) {
    const bf16* wt = (const bf16*)(ws + OFF_LW) + (size_t)(((oi * 2 + d) * 8 + g) * 2) * 4096 + (nt_g * 32 + lr_g) * 64 + lh_g * 8;
#pragma unroll
    for (int ks = 0; ks < 4; ++ks) { wfa[d][ks] = *(const bf16x8*)(wt + ks * 16); wfx[d][ks] = *(const bf16x8*)(wt + 4096 + ks * 16); }
    pba[d] = p.in[I_BA][(oi * 2 + d) * 512 + chj_g]; pbx[d] = p.in[I_BX][(oi * 2 + d) * 512 + chj_g]; plam[d] = p.in[I_LAMBDA][(oi * 2 + d) * 512 + chj_g];
  }
  float hs[16];
#pragma unroll
  for (int i = 0; i < 16; ++i) hs[i] = 0.f;
  float2* car = (float2*)(ws + OFF_CAR);

#pragma unroll
  for (int d = 0; d < 2; ++d) {
    __syncthreads();
    {
      const int wave = __builtin_amdgcn_readfirstlane(tid >> 6);
      const int lane = tid & 63, lr = lane & 31, lh = lane >> 5;
      const int mt = wave >> 1, nt = wave & 1;
      const bf16* wt = (const bf16*)(ws + OFF_LW) + (size_t)(((oi * 2 + d) * 8 + g) * 2) * 4096 + (nt * 32 + lr) * 64 + lh * 8;
      f32x16 ca, cx;
#pragma unroll
      for (int i = 0; i < 16; ++i) { ca[i] = 0.f; cx[i] = 0.f; }
#pragma unroll
      for (int ks = 0; ks < 4; ++ks) {
        const bf16x8 af = *(const bf16x8*)(ubf + (mt * 32 + lr) * 144 + ks * 32 + lh * 16);
        ca = MFMA(af, wfa[d][ks], ca);
        cx = MFMA(af, wfx[d][ks], cx);
      }
      const int cj = nt * 32 + lr, chj = g * 64 + cj;
      const float ba = pba[d], bx = pbx[d];
      const float sp = log1pf(__expf(-plam[d]));
#pragma unroll
      for (int i = 0; i < 16; ++i) {
        const int t = mt * 32 + crow(i, lh);
        const float r = sigm(ca[i] + ba), ig = sigm(cx[i] + bx);
        const float a = __expf(-8.f * r * sp);
        const float b = __builtin_amdgcn_sqrtf(fmaxf(1.f - a * a, 0.f)) * (ig * us[t * 64 + cj]);
        ab[t * 64 + cj] = make_float2(a, b);
      }
    }
    __syncthreads();
    float ar[16], ai[16];
    float Ap = 1.f, Bp = 0.f;
#pragma unroll
    for (int q = 0; q < 16; ++q) {
      const int tt = d ? 15 - q : q;
      const float2 v = ab[(tg * 16 + tt) * 64 + j];
      ar[tt] = v.x; ai[tt] = v.y;
      Bp = v.x * Bp + v.y; Ap *= v.x;
    }
    seg[tg * 64 + j] = make_float2(Ap, Bp);
    __syncthreads();
    if (!PASS2) {
      if (tg == 0) {
        float A = 1.f, B = 0.f;
#pragma unroll
        for (int q = 0; q < 4; ++q) { float2 sg = seg[(d ? 3 - q : q) * 64 + j]; B = sg.x * B + sg.y; A *= sg.x; }
        car[(size_t)(chunk * 2 + d) * 512 + ch] = make_float2(A, B);
      }
    } else {
      float h = 0.f;
#pragma unroll
      for (int q = 0; q < 4; ++q) { float2 sg = seg2[(d * 4 + q) * 64 + j]; h = sg.x * h + sg.y; }
      if (d == 0) {
        for (int q = 0; q < tg; ++q) { float2 sg = seg[q * 64 + j]; h = sg.x * h + sg.y; }
#pragma unroll
        for (int tt = 0; tt < 16; ++tt) { h = ar[tt] * h + ai[tt]; hs[tt] += h; }
      } else {
        for (int q = 3; q > tg; --q) { float2 sg = seg[q * 64 + j]; h = sg.x * h + sg.y; }
#pragma unroll
        for (int tt = 15; tt >= 0; --tt) { h = ar[tt] * h + ai[tt]; hs[tt] += h; }
      }
    }
  }
  if (PASS2) {
    const bf16* G = (const bf16*)(ws + OFF_G);
    bf16* Y = (bf16*)(ws + OFF_HY);
#pragma unroll
    for (int tt = 0; tt < 16; ++tt) {
      const size_t o = (size_t)(t0 + tg * 16 + tt) * 1024 + 512 + ch;
      Y[o] = f2bf(hs[tt] * silu(bf2f(G[o])));
    }
  }
}


DI void grid_barrier(unsigned* bar, unsigned k, unsigned nb) {
  asm volatile("s_waitcnt vmcnt(0) lgkmcnt(0)" ::: "memory");
  __syncthreads();
  if (threadIdx.x == 0) {
    __builtin_amdgcn_fence(__ATOMIC_RELEASE, "agent");
    asm volatile("s_waitcnt vmcnt(0)" ::: "memory");
    const unsigned g = blockIdx.x & 7u;
    const unsigned ngroups = nb < 8u ? nb : 8u;
    const unsigned gsize = (nb - g + 7u) >> 3;
    const unsigned old = __hip_atomic_fetch_add(bar + 128 + 32 * g, 1u, __ATOMIC_RELAXED, __HIP_MEMORY_SCOPE_AGENT);
    if (old == gsize * k - 1u) {
      const unsigned old2 = __hip_atomic_fetch_add(bar, 1u, __ATOMIC_RELAXED, __HIP_MEMORY_SCOPE_AGENT);
      if (old2 == ngroups * k - 1u) __hip_atomic_store(bar + 64, k, __ATOMIC_RELAXED, __HIP_MEMORY_SCOPE_AGENT);
    }
    while (__hip_atomic_load(bar + 64, __ATOMIC_RELAXED, __HIP_MEMORY_SCOPE_AGENT) < k) __builtin_amdgcn_s_sleep(4);
    __builtin_amdgcn_fence(__ATOMIC_ACQUIRE, "agent");
    asm volatile("s_waitcnt vmcnt(0)" ::: "memory");
  }
  __syncthreads();
}

DI int grab_item(unsigned* ctr, int base, int wv, int* slot) {
  const int t = launder(wv);
  __syncthreads();
  if (t == 0) *slot = base + (int)__hip_atomic_fetch_add(ctr, 1u, __ATOMIC_RELAXED, __HIP_MEMORY_SCOPE_AGENT);
  __syncthreads();
  return __builtin_amdgcn_readfirstlane(*slot);
}

constexpr int N_PHASES = 22;

__global__ void __launch_bounds__(256, 2) mega(Params p, int ph_lo, int ph_hi) {
  __shared__ __attribute__((aligned(16))) unsigned char smem[LDS_BYTES];
  __shared__ int s_item;
  const int tid = __builtin_amdgcn_readfirstlane(threadIdx.x >> 6);
  const int nb = gridDim.x;
  if ((int)blockIdx.x >= (nb >> 1)) __builtin_amdgcn_s_setprio(1);
#pragma unroll 1
  for (int ph = ph_lo; ph < ph_hi; ++ph) {
    if (ph > ph_lo) {
      if (ph_hi < 0) cg::this_grid().sync();
      grid_barrier((unsigned*)(p.ws + OFF_BAR), (unsigned)(ph - ph_lo), (unsigned)nb);
    }
    if (ph == 0) {
      constexpr int n_items = 192 + 64 + 24 + N_WEARLY;
      unsigned* ctr0 = (unsigned*)(p.ws + OFF_BAR) + 32;
      for (int it = blockIdx.x; it < n_items; it = grab_item(ctr0, nb, tid, &s_item)) {
        if (it < 192) prep_mod(p, smem, it, tid);
        else if (it < 256) prep_lruw(p, smem, it - 192, tid);
        else if (it < 280) prep_tab(p, it - 256, tid);
        else prep_wtile(p, smem, it - 280, tid);
      }
      continue;
    }
    if (ph == N_PHASES - 1) {
      for (int it = blockIdx.x; it < 4096; it += nb) final_rows(p, it, tid);
      continue;
    }
    const int layer = (ph - 1) / 5, sub = (ph - 1) % 5;
    const bool odd = layer & 1;
    unsigned* ctr = (unsigned*)(p.ws + OFF_BAR) + 32 + ph;
#define NEXT_ITEM grab_item(ctr, nb, tid, &s_item)
    if (sub == 0) {
      for (int it = blockIdx.x; it < NT / 4; it += nb) norm_rows(p, layer, it, tid);
    } else if (sub == 1) {
      if (!odd) { for (int it = blockIdx.x; it < 130 * 26; it = NEXT_ITEM) gemm_tile<EP_EVEN_IN>(p, smem, layer, it / 26, it % 26, tid); }
      else { for (int it = blockIdx.x; it < 130 * 24; it = NEXT_ITEM) gemm_tile<EP_ODD_IN>(p, smem, layer, it / 24, it % 24, tid); }
    } else if (sub == 2) {
      if (!odd) {
        for (int it = blockIdx.x; it < 130 * 14; it = NEXT_ITEM) {
          const int mt = it / 14, nt = it % 14;
          if (nt < 6) gemm_tile<EP_UPQ>(p, smem, layer, mt, nt, tid);
          else gemm_tile<EP_UPKV>(p, smem, layer, mt, nt - 6, tid);
        }
      } else {
        for (int it = blockIdx.x; it < NCHUNK * 8; it = NEXT_ITEM) lru_item<false>(p, smem, layer, it >> 3, it & 7, tid);
      }
    } else if (sub == 3) {
      if (!odd) {
        const int n_fill = (layer == 0) ? (N_WTILES - N_WEARLY) : 0;
        for (int it = blockIdx.x; it < 520 + 1040 + n_fill; it = NEXT_ITEM) {
          if (it >= 1560) { prep_wtile(p, smem, N_WEARLY + it - 1560, tid); continue; }
          if (it < 520) {
            const int head = it & 7, pi = it >> 3;
            const int qb = pi < 64 ? 2 + 2 * pi : 0;
            attn_item<96, 64, 1, 0, 2>(p, smem, layer, qb, head, tid);
          } else {
            const int idx = it - 520;
            const int head = idx & 7, qbi = idx >> 3;
            const int qb = qbi < 128 ? qbi + 2 : qbi - 128;
            attn_item<64, 64, 1, 1, 1>(p, smem, layer, qb, head, tid);
          }
        }
      } else {
        for (int it = blockIdx.x; it < 520 + NCHUNK * 8; it = NEXT_ITEM) {
          if (it < 520) {
            const int head = it & 3, qbi = it >> 2;
            const int qb = qbi < 128 ? qbi + 2 : qbi - 128;
#ifndef NO_DIFF
            attn_item<64, 128, 2, 2, 1>(p, smem, layer, qb, head, tid);
#endif
          } else {
            const int k = it - 520;
#ifndef NO_LRU
            lru_item<true>(p, smem, layer, k >> 3, k & 7, tid);
#endif
          }
        }
      }
    } else {
      const int skip = (layer == 3) ? 16 : 0;
      for (int it = blockIdx.x; it < 130 * 8 - skip; it = NEXT_ITEM) gemm_tile<EP_OUT>(p, smem, layer, (it + skip) >> 3, (it + skip) & 7, tid);
    }
  }
}

extern "C" void kernel_launch(void* const* d_in, const int* in_sizes, int n_in, void* d_out, int out_size, void* d_ws, size_t ws_size,
                              hipStream_t stream) {
  static int grid_blocks = 0;
  if (!grid_blocks) {
    int dev = 0, cus = 0, per_cu = 0;
    hipGetDevice(&dev);
    hipDeviceGetAttribute(&cus, hipDeviceAttributeMultiprocessorCount, dev);
    hipOccupancyMaxActiveBlocksPerMultiprocessor(&per_cu, mega, 256, 0);
    if (per_cu < 1) per_cu = 1;
    if (per_cu > 2) per_cu = 2;
    grid_blocks = cus * per_cu;
    if (ws_size < WS_END) fprintf(stderr, "kernel_launch: workspace too small (%zu < %zu)\n", ws_size, (size_t)WS_END);
  }
  Params p{};
  for (int i = 0; i < 29; ++i) p.in[i] = (const float*)d_in[i];
  p.out = (float*)d_out; p.ws = (unsigned char*)d_ws;
#if COOP
  hipMemsetAsync((unsigned char*)d_ws + OFF_BAR, 0, 2048, stream);
  int lo = 0, hi = N_PHASES;
  void* args[] = {&p, &lo, &hi};
  hipError_t e = hipLaunchCooperativeKernel((void*)mega, dim3(grid_blocks), dim3(256), args, 0, stream);
  if (e != hipSuccess) fprintf(stderr, "cooperative launch failed: %s (grid %d)\n", hipGetErrorString(e), grid_blocks);
#else
  for (int ph = 0; ph < N_PHASES; ++ph) hipLaunchKernelGGL(mega, dim3(grid_blocks), dim3(256), 0, stream, p, ph, ph + 1);
#endif
}
```

```cpp
#include <hip/hip_runtime.h>
#include <hip/hip_cooperative_groups.h>
#include <cstdio>
namespace cg = cooperative_groups;

#ifndef COOP
#define COOP 1
#endif

#define DI __device__ __forceinline__
typedef unsigned short bf16;
using bf16x8 = __attribute__((ext_vector_type(8))) short;
using f32x16 = __attribute__((ext_vector_type(16))) float;
typedef __bf16 v2bf __attribute__((ext_vector_type(2)));
typedef float v2f __attribute__((ext_vector_type(2)));
typedef unsigned u32x4 __attribute__((ext_vector_type(4)));
typedef unsigned u32x2 __attribute__((ext_vector_type(2)));
#define MFMA(a, b, c) __builtin_amdgcn_mfma_f32_32x32x16_bf16((a), (b), (c), 0, 0, 0)

constexpr int NT = 16640;
constexpr int NCTX = 256;
constexpr int E_IN = 3232, E_INP = 3328, O_IN = 3072;
constexpr float EPS = 1e-6f;
constexpr float LOG2E = 1.4426950408889634f;
constexpr int NCHUNK = 260;

constexpr size_t al(size_t x) { return (x + 255) & ~size_t(255); }
constexpr size_t OFF_XC   = 0;
constexpr size_t OFF_MOD  = OFF_XC + al(256 * 1024 * 4);
constexpr size_t OFF_T64  = OFF_MOD + al(4 * 2 * 3072 * 4);
constexpr size_t OFF_T32  = OFF_T64 + al(256 * 16 * 8);
constexpr size_t OFF_CAR  = OFF_T32 + al(256 * 8 * 8);
constexpr size_t SZ_WEIN  = (size_t)E_INP * 1024 * 2;
constexpr size_t SZ_WOUT  = (size_t)1024 * 1024 * 2;
constexpr size_t SZ_WUQ   = (size_t)768 * 384 * 2;
constexpr size_t SZ_WUKV  = (size_t)1024 * 256 * 2;
constexpr size_t SZ_WOIN  = (size_t)O_IN * 1024 * 2;
constexpr size_t OFF_WEIN = OFF_CAR + al(NCHUNK * 2 * 512 * 8);
constexpr size_t OFF_WEOUT = OFF_WEIN + 2 * SZ_WEIN;
constexpr size_t OFF_WUQ  = OFF_WEOUT + 2 * SZ_WOUT;
constexpr size_t OFF_WUKV = OFF_WUQ + 2 * SZ_WUQ;
constexpr size_t OFF_WOIN = OFF_WUKV + 2 * SZ_WUKV;
constexpr size_t OFF_WOOUT = OFF_WOIN + 2 * SZ_WOIN;
constexpr size_t OFF_HY   = OFF_WOOUT + 2 * SZ_WOUT;
constexpr size_t OFF_G    = OFF_HY + (size_t)NT * 1024 * 2;
constexpr size_t SZ_H64   = (size_t)8 * NT * 64 * 2;
constexpr size_t OFF_QA   = OFF_G + (size_t)NT * 1024 * 2;
constexpr size_t OFF_KA   = OFF_QA + SZ_H64;
constexpr size_t OFF_VAT  = OFF_KA + SZ_H64;
constexpr size_t OFF_QL   = OFF_VAT + SZ_H64;
constexpr size_t OFF_KVL  = OFF_QL + (size_t)NT * 384 * 2;
constexpr size_t OFF_QM   = OFF_KVL + (size_t)NT * 256 * 2;
constexpr size_t OFF_KM   = OFF_QM + (size_t)8 * NT * 96 * 2;
constexpr size_t OFF_VMT  = OFF_KM + (size_t)8 * NT * 96 * 2;
constexpr size_t OFF_BAR  = OFF_VMT + SZ_H64;
constexpr size_t OFF_LW   = OFF_BAR + 2048;
constexpr size_t WS_END   = OFF_LW + (size_t)64 * 4096 * 2;
static_assert(WS_END <= (size_t)256 * 1024 * 1024, "workspace too large");

constexpr int LDS_BYTES = 63 * 1024;

struct Params { const float* in[29]; float* out; unsigned char* ws; };

enum { I_X = 0, I_C, I_CTX, I_CCTX, I_MODW, I_MODB, I_NORMG, I_FINALG, I_EWIN, I_EWOUT, I_RPB, I_QNORM, I_WUQ, I_KVNORM, I_WUKV,
       I_OWIN, I_OWOUT, I_LQ1, I_LK1, I_LQ2, I_LK2, I_SUBLN, I_CONVW, I_CONVB, I_LAMBDA, I_WA, I_BA, I_WX, I_BX };

DI float bf2f(bf16 u) { return __uint_as_float(((unsigned)u) << 16); }
DI unsigned pack2(float a, float b) { v2f x = {a, b}; v2bf r = __builtin_convertvector(x, v2bf); return __builtin_bit_cast(unsigned, r); }
DI bf16 f2bf(float x) { return (bf16)pack2(x, x); }
DI int crow(int i, int h) { return (i & 3) + 8 * (i >> 2) + 4 * h; }
DI float sigm(float x) { return __builtin_amdgcn_rcpf(1.f + __expf(-x)); }
DI float silu(float x) { return x * sigm(x); }
DI float wave_sum(float v) {
#pragma unroll
  for (int o = 32; o > 0; o >>= 1) v += __shfl_xor(v, o);
  return v;
}
DI int launder(int wv) { int l; asm volatile("v_mbcnt_lo_u32_b32 %0, -1, 0\n\tv_mbcnt_hi_u32_b32 %0, -1, %0" : "=v"(l)); return (wv << 6) + l; }
DI float* xrow(const Params& p, int row) {
  return row < NCTX ? (float*)(p.ws + OFF_XC) + (size_t)row * 1024 : p.out + (size_t)(row - NCTX) * 1024;
}

DI const float* xrow_in(const Params& p, int row) {
  return row < NCTX ? p.in[I_CTX] + (size_t)row * 1024 : p.in[I_X] + (size_t)(row - NCTX) * 1024;
}

DI void prep_wtile(const Params& p, unsigned char* smem, int item, int tid) {
  tid = launder(tid);
  int lay = 0, kind = 0, K = 0, N = 0, NP = 0; const float* src = nullptr; const float* gv = nullptr; bf16* dst = nullptr;
  int rem = item;
  const unsigned long long order = 0xBA9875312640ull;
#pragma unroll 1
  for (int q = 0; q < 12; ++q) {
    const int d = (int)((order >> (4 * q)) & 15ull);
    kind = d >> 1; lay = d & 1;
    switch (kind) {
      case 0: K = 1024; N = E_IN; NP = E_INP; break;
      case 1: K = 1024; N = 1024; NP = 1024; break;
      case 2: K = 384; N = 768; NP = 768; break;
      case 3: K = 256; N = 1024; NP = 1024; break;
      case 4: K = 1024; N = O_IN; NP = O_IN; break;
      default: K = 1024; N = 1024; NP = 1024; break;
    }
    int nt = (K >> 6) * (NP >> 6);
    if (rem < nt) break;
    rem -= nt;
  }
  switch (kind) {
    case 0: src = p.in[I_EWIN] + (size_t)lay * 1024 * E_IN; dst = (bf16*)(p.ws + OFF_WEIN + lay * SZ_WEIN); break;
    case 1: src = p.in[I_EWOUT] + (size_t)lay * 1024 * 1024; dst = (bf16*)(p.ws + OFF_WEOUT + lay * SZ_WOUT); break;
    case 2: src = p.in[I_WUQ] + (size_t)lay * 384 * 768; dst = (bf16*)(p.ws + OFF_WUQ + lay * SZ_WUQ); gv = p.in[I_QNORM] + lay * 384; break;
    case 3: src = p.in[I_WUKV] + (size_t)lay * 256 * 1024; dst = (bf16*)(p.ws + OFF_WUKV + lay * SZ_WUKV); gv = p.in[I_KVNORM] + lay * 256; break;
    case 4: src = p.in[I_OWIN] + (size_t)lay * 1024 * O_IN; dst = (bf16*)(p.ws + OFF_WOIN + lay * SZ_WOIN); break;
    default: src = p.in[I_OWOUT] + (size_t)lay * 1024 * 1024; dst = (bf16*)(p.ws + OFF_WOOUT + lay * SZ_WOUT); break;
  }
  const int ktiles = K >> 6;
  const int k0 = (rem % ktiles) * 64, n0 = (rem / ktiles) * 64;
  float* t = (float*)smem;
  __syncthreads();
#pragma unroll
  for (int i = 0; i < 16; ++i) {
    int k = i * 4 + (tid >> 6), n = tid & 63;
    float v = 0.f;
    if (n0 + n < N) { v = src[(size_t)(k0 + k) * N + n0 + n]; if (gv) v *= gv[k0 + k]; }
    t[k * 65 + n] = v;
  }
  __syncthreads();
#pragma unroll
  for (int i = 0; i < 16; ++i) {
    int n = i * 4 + (tid >> 6), k = tid & 63;
    dst[(size_t)(n0 + n) * K + k0 + k] = f2bf(t[k * 65 + n]);
  }
}
constexpr int N_WTILES = 2 * (16 * 52 + 256 + 6 * 12 + 4 * 16 + 16 * 48 + 256);
constexpr int N_WEARLY = 16 * 52 + 6 * 12 + 4 * 16 + 256;

DI void prep_lruw(const Params& p, unsigned char* smem, int item, int tid) {
  tid = launder(tid);
  const int which = item & 1, m = item >> 1;
  const float* src = (which ? p.in[I_WX] : p.in[I_WA]) + (size_t)m * 4096;
  bf16* dst = (bf16*)(p.ws + OFF_LW) + (size_t)item * 4096;
  float* t = (float*)smem;
  __syncthreads();
#pragma unroll
  for (int i = 0; i < 16; ++i) { int k = i * 4 + (tid >> 6), n = tid & 63; t[k * 65 + n] = src[k * 64 + n]; }
  __syncthreads();
#pragma unroll
  for (int i = 0; i < 16; ++i) { int n = i * 4 + (tid >> 6), k = tid & 63; dst[n * 64 + k] = f2bf(t[k * 65 + n]); }
}


DI void prep_mod(const Params& p, unsigned char* smem, int item, int tid) {
  tid = launder(tid);
  const int l = item / 48, cb = item % 48;
  const int col = cb * 64 + (tid & 63), kg = tid >> 6;
  const float* w = p.in[I_MODW] + (size_t)l * 1024 * 3072;
  float* sv = (float*)smem + 512;
  __syncthreads();
#pragma unroll
  for (int i = 0; i < 4; ++i) { int k = tid + 256 * i; sv[k] = silu(p.in[I_C][k]); sv[1024 + k] = silu(p.in[I_CCTX][k]); }
  __syncthreads();
  float aL = 0.f, aC = 0.f;
#pragma unroll 16
  for (int k = kg * 256; k < kg * 256 + 256; ++k) {
    float wv = w[(size_t)k * 3072 + col];
    aL += sv[k] * wv;
    aC += sv[1024 + k] * wv;
  }
  float* t = (float*)smem;
  __syncthreads();
  t[tid] = aL; t[256 + tid] = aC;
  __syncthreads();
  if (tid < 64) {
    float b = p.in[I_MODB][l * 3072 + col];
    float sL = t[tid] + t[64 + tid] + t[128 + tid] + t[192 + tid] + b;
    float sC = t[256 + tid] + t[320 + tid] + t[384 + tid] + t[448 + tid] + b;
    float* mod = (float*)(p.ws + OFF_MOD);
    mod[(l * 2 + 0) * 3072 + col] = sL;
    mod[(l * 2 + 1) * 3072 + col] = sC;
  }
}

DI void prep_tab(const Params& p, int item, int tid) {
  tid = launder(tid);
  int e = item * 256 + tid;
  if (e < 4096) {
    int pos = e >> 4, f = e & 15;
    float inv = powf(10000.f, -(float)f / 16.f);
    float a = (float)pos * inv, s, c; sincosf(a, &s, &c);
    ((float2*)(p.ws + OFF_T64))[e] = make_float2(c, s);
  } else {
    e -= 4096;
    int pos = e >> 3, f = e & 7;
    float inv = powf(10000.f, -(float)f / 8.f);
    float a = (float)pos * inv, s, c; sincosf(a, &s, &c);
    ((float2*)(p.ws + OFF_T32))[e] = make_float2(c, s);
  }
}

DI void prep_copy(const Params& p, int item, int tid) {
  tid = launder(tid);
#pragma unroll 4
  for (int i = 0; i < 16; ++i) {
    int row = item * 16 + i;
    const float* s = row < NCTX ? p.in[I_CTX] + (size_t)row * 1024 : p.in[I_X] + (size_t)(row - NCTX) * 1024;
    ((float4*)xrow(p, row))[tid] = ((const float4*)s)[tid];
  }
}

DI void norm_rows(const Params& p, int l, int item, int tid) {
  tid = launder(tid);
  const int row = item * 4 + (tid >> 6), lane = tid & 63;
  const float* x = (l == 0) ? xrow_in(p, row) : (const float*)xrow(p, row);
  float4 v[4]; float ss = 0.f;
#pragma unroll
  for (int i = 0; i < 4; ++i) { v[i] = ((const float4*)x)[i * 64 + lane]; ss += v[i].x * v[i].x + v[i].y * v[i].y + v[i].z * v[i].z + v[i].w * v[i].w; }
  ss = wave_sum(ss);
  const float rstd = rsqrtf(ss * (1.f / 1024.f) + EPS);
  const float* mod = (const float*)(p.ws + OFF_MOD) + (l * 2 + (row < NCTX ? 1 : 0)) * 3072;
  const float* g = p.in[I_NORMG] + l * 1024;
  bf16* h = (bf16*)(p.ws + OFF_HY) + (size_t)row * 1024;
#pragma unroll
  for (int i = 0; i < 4; ++i) {
    int k = (i * 64 + lane) * 4;
    float4 gg = *(const float4*)(g + k), sh = *(const float4*)(mod + k), sc = *(const float4*)(mod + 1024 + k);
    float a = v[i].x * rstd * gg.x * (1.f + sc.x) + sh.x;
    float b = v[i].y * rstd * gg.y * (1.f + sc.y) + sh.y;
    float c = v[i].z * rstd * gg.z * (1.f + sc.z) + sh.z;
    float d = v[i].w * rstd * gg.w * (1.f + sc.w) + sh.w;
    u32x2 o = {pack2(a, b), pack2(c, d)};
    *(u32x2*)(h + k) = o;
  }
}

DI void final_rows(const Params& p, int item, int tid) {
  tid = launder(tid);
  const int row = item * 4 + (tid >> 6), lane = tid & 63;
  float* x = p.out + (size_t)row * 1024;
  float4 v[4]; float ss = 0.f;
#pragma unroll
  for (int i = 0; i < 4; ++i) { v[i] = ((const float4*)x)[i * 64 + lane]; ss += v[i].x * v[i].x + v[i].y * v[i].y + v[i].z * v[i].z + v[i].w * v[i].w; }
  ss = wave_sum(ss);
  const float rstd = rsqrtf(ss * (1.f / 1024.f) + EPS);
  const float* g = p.in[I_FINALG];
#pragma unroll
  for (int i = 0; i < 4; ++i) {
    int k = (i * 64 + lane) * 4;
    float4 gg = *(const float4*)(g + k);
    float4 o = make_float4(v[i].x * rstd * gg.x, v[i].y * rstd * gg.y, v[i].z * rstd * gg.z, v[i].w * rstd * gg.w);
    *(float4*)(x + k) = o;
  }
}

template <bool TR>
DI void gemm_k(const bf16* __restrict__ A, int lda, const bf16* __restrict__ B, int ldb, int K, unsigned char* smem,
               f32x16 (&acc)[2][2], int tid, int lane, int wm, int wn) {
  const int lr = lane & 31, lh = lane >> 5;
  u32x4 ra[4], rb[4];
#pragma unroll
  for (int i = 0; i < 4; ++i) {
    int c = tid + 256 * i, row = c >> 3, cj = c & 7;
    ra[i] = *(const u32x4*)(A + (size_t)row * lda + cj * 8);
    rb[i] = *(const u32x4*)(B + (size_t)row * ldb + cj * 8);
  }
#pragma unroll 1
  for (int k0 = 0; k0 < K; k0 += 64) {
    __syncthreads();
#pragma unroll
    for (int i = 0; i < 4; ++i) {
      int c = tid + 256 * i, row = c >> 3, cj = c & 7;
      *(u32x4*)(smem + row * 144 + cj * 16) = ra[i];
      *(u32x4*)(smem + 18432 + row * 144 + cj * 16) = rb[i];
    }
    __syncthreads();
    if (k0 + 64 < K) {
#pragma unroll
      for (int i = 0; i < 4; ++i) {
        int c = tid + 256 * i, row = c >> 3, cj = c & 7;
        ra[i] = *(const u32x4*)(A + (size_t)row * lda + k0 + 64 + cj * 8);
        rb[i] = *(const u32x4*)(B + (size_t)row * ldb + k0 + 64 + cj * 8);
      }
    }
#pragma unroll
    for (int ks = 0; ks < 4; ++ks) {
      bf16x8 af[2], bfr[2];
#pragma unroll
      for (int t = 0; t < 2; ++t) {
        af[t] = *(const bf16x8*)(smem + (wm * 64 + t * 32 + lr) * 144 + ks * 32 + lh * 16);
        bfr[t] = *(const bf16x8*)(smem + 18432 + (wn * 64 + t * 32 + lr) * 144 + ks * 32 + lh * 16);
      }
#pragma unroll
      for (int mt = 0; mt < 2; ++mt)
#pragma unroll
        for (int nt = 0; nt < 2; ++nt)
          acc[mt][nt] = TR ? MFMA(bfr[nt], af[mt], acc[mt][nt]) : MFMA(af[mt], bfr[nt], acc[mt][nt]);
    }
  }
}

enum { EP_EVEN_IN = 0, EP_UPQ, EP_UPKV, EP_ODD_IN, EP_OUT };

DI void st_tile_rm(bf16* base, size_t row_stride, int m0, int lh, const f32x16& a, float s0 = 1.f) {
#pragma unroll
  for (int i = 0; i < 16; ++i) base[(size_t)(m0 + crow(i, lh)) * row_stride] = f2bf(a[i] * s0);
}

DI void stage_val(unsigned char* wl, int row, int col, float v) { *(bf16*)(wl + row * 144 + col * 2) = f2bf(v); }
DI void flush_unit(const unsigned char* wl, int nt, int lane, bf16* base, int stride) {
#pragma unroll
  for (int j = 0; j < 4; ++j) {
    const int c = lane + 64 * j, row = c >> 2, ch = c & 3;
    const u32x4 d = *(const u32x4*)(wl + row * 144 + nt * 64 + ch * 16);
    *(u32x4*)(base + (size_t)row * stride + ch * 8) = d;
  }
}

template <int MODE>
DI void gemm_tile(const Params& p, unsigned char* smem, int layer, int mtile, int ntile, int tid) {
  tid = launder(tid);
  const int li = layer >> 1;
  const int lane = tid & 63, lr = lane & 31, lh = lane >> 5;
  const int wave = __builtin_amdgcn_readfirstlane(tid >> 6);
  const int wm = wave >> 1, wn = wave & 1;
  const int m0 = mtile * 128, n0 = ntile * 128;
  const int m0w = m0 + wm * 64, n0w = n0 + wn * 64;
  const bool is_lat = m0 >= NCTX;
  unsigned char* ws = p.ws;
  const bf16* A; const bf16* B; int lda, K;
  bool tr = false;
  if (MODE == EP_EVEN_IN) { A = (const bf16*)(ws + OFF_HY); lda = 1024; K = 1024; B = (const bf16*)(ws + OFF_WEIN + li * SZ_WEIN); tr = (n0w >= 1024 && n0w < 1536); }
  else if (MODE == EP_ODD_IN) { A = (const bf16*)(ws + OFF_HY); lda = 1024; K = 1024; B = (const bf16*)(ws + OFF_WOIN + li * SZ_WOIN); tr = (n0w >= 1024 && n0w < 1536); }
  else if (MODE == EP_UPQ) { A = (const bf16*)(ws + OFF_QL); lda = 384; K = 384; B = (const bf16*)(ws + OFF_WUQ + li * SZ_WUQ); }
  else if (MODE == EP_UPKV) { A = (const bf16*)(ws + OFF_KVL); lda = 256; K = 256; B = (const bf16*)(ws + OFF_WUKV + li * SZ_WUKV); tr = ((n0w >> 6) & 1) != 0; }
  else { A = (const bf16*)(ws + OFF_HY); lda = 1024; K = 1024; B = (const bf16*)(ws + ((layer & 1) ? OFF_WOOUT : OFF_WEOUT) + li * SZ_WOUT); }
  A += (size_t)m0 * lda; B += (size_t)n0 * K;

  float* rs = (float*)(smem + 36864);
  if (MODE == EP_UPQ || MODE == EP_UPKV) {
    __syncthreads();
    const int row = tid >> 1, half = tid & 1, hk = K >> 1;
    const bf16* ar = A + (size_t)row * lda + half * hk;
    float ss = 0.f;
    for (int k = 0; k < hk; k += 8) {
      u32x4 u = *(const u32x4*)(ar + k);
      unsigned w4[4] = {u.x, u.y, u.z, u.w};
#pragma unroll
      for (int j = 0; j < 4; ++j) { float a = __uint_as_float(w4[j] << 16), b = __uint_as_float(w4[j] & 0xffff0000u); ss += a * a + b * b; }
    }
    ss += __shfl_xor(ss, 1);
    if (half == 0) rs[row] = rsqrtf(ss / (float)K + EPS);
  }

  f32x16 acc[2][2];
#pragma unroll
  for (int a = 0; a < 2; ++a)
#pragma unroll
    for (int b = 0; b < 2; ++b)
#pragma unroll
      for (int i = 0; i < 16; ++i) acc[a][b][i] = 0.f;
  if (tr) gemm_k<true>(A, lda, B, K, K, smem, acc, tid, lane, wm, wn);
  else gemm_k<false>(A, lda, B, K, K, smem, acc, tid, lane, wm, wn);
  if (MODE == EP_EVEN_IN || MODE == EP_ODD_IN) __syncthreads();
  unsigned char* wl = smem + wave * 9216;

  if (MODE == EP_OUT) {
    const float* gm = (const float*)(ws + OFF_MOD) + (layer * 2 + (is_lat ? 0 : 1)) * 3072 + 2048;
#pragma unroll
    for (int mt = 0; mt < 2; ++mt)
#pragma unroll
      for (int nt = 0; nt < 2; ++nt) {
        const int n = n0w + nt * 32 + lr; const float g = gm[n];
#pragma unroll
        for (int i = 0; i < 16; ++i) {
          const int m = m0w + mt * 32 + crow(i, lh);
          float* x = xrow(p, m) + n;
          const float xin = (layer == 0) ? xrow_in(p, m)[n] : *x;
          *x = xin + g * acc[mt][nt][i];
        }
      }
    return;
  }
  if (MODE == EP_UPQ) {
    const float2* t32 = (const float2*)(ws + OFF_T32);
#pragma unroll
    for (int mt = 0; mt < 2; ++mt)
#pragma unroll
      for (int nt = 0; nt < 2; ++nt) {
        const int nn = n0w + nt * 32, head = nn / 96, j0 = nn % 96;
        bf16* dst = (bf16*)(ws + OFF_QM) + (size_t)head * NT * 96 + j0 + lr;
        const bool rope = (j0 == 64) && is_lat;
#pragma unroll
        for (int i = 0; i < 16; ++i) {
          const int ml = wm * 64 + mt * 32 + crow(i, lh), m = m0 + ml;
          float v = acc[mt][nt][i] * rs[ml];
          if (rope) {
            float pv = __shfl_xor(v, 16);
            int t = m - NCTX, idx = lr & 15, pos = (idx < 8) ? (t >> 6) : (t & 63);
            float2 cs = t32[pos * 8 + (idx & 7)];
            v = (lr < 16) ? (v * cs.x - pv * cs.y) : (pv * cs.y + v * cs.x);
          }
          dst[(size_t)m * 96] = f2bf(v);
        }
      }
    return;
  }
  if (MODE == EP_UPKV) {
    const int head = n0w >> 7;
    if (!tr) {
#pragma unroll
      for (int mt = 0; mt < 2; ++mt)
#pragma unroll
        for (int nt = 0; nt < 2; ++nt) {
          bf16* dst = (bf16*)(ws + OFF_KM) + (size_t)head * NT * 96 + nt * 32 + lr;
#pragma unroll
          for (int i = 0; i < 16; ++i) { const int ml = wm * 64 + mt * 32 + crow(i, lh); dst[(size_t)(m0 + ml) * 96] = f2bf(acc[mt][nt][i] * rs[ml]); }
        }
    } else {
#pragma unroll
      for (int mt = 0; mt < 2; ++mt)
#pragma unroll
        for (int nt = 0; nt < 2; ++nt) {
          const int ml = wm * 64 + mt * 32 + lr; const float r = rs[ml];
          bf16* dst = (bf16*)(ws + OFF_VMT) + (size_t)head * 64 * NT + m0 + ml;
#pragma unroll
          for (int i = 0; i < 16; ++i) dst[(size_t)(nt * 32 + crow(i, lh)) * NT] = f2bf(acc[mt][nt][i] * r);
        }
    }
    return;
  }
  if (MODE == EP_EVEN_IN) {
    if (tr) {
#pragma unroll
      for (int mt = 0; mt < 2; ++mt)
#pragma unroll
        for (int nt = 0; nt < 2; ++nt) {
          const int nb = n0w - 1024 + nt * 32, m = m0w + mt * 32 + lr;
          bf16* dst = (bf16*)(ws + OFF_VAT) + (size_t)nb * NT + m;
#pragma unroll
          for (int i = 0; i < 16; ++i) dst[(size_t)crow(i, lh) * NT] = f2bf(acc[mt][nt][i]);
        }
      return;
    }
    const float2* t32 = (const float2*)(ws + OFF_T32);
#pragma unroll
    for (int mt = 0; mt < 2; ++mt)
#pragma unroll
      for (int nt = 0; nt < 2; ++nt) {
        const int nn = n0w + nt * 32;
        const bool krope = (nn >= 2688 && nn < 2720);
#pragma unroll
        for (int i = 0; i < 16; ++i) {
          const int ml = mt * 32 + crow(i, lh), m = m0w + ml;
          float v = acc[mt][nt][i];
          if (krope && is_lat) {
            float pv = __shfl_xor(v, 16);
            int t = m - NCTX, idx = lr & 15, pos = (idx < 8) ? (t >> 6) : (t & 63);
            float2 cs = t32[pos * 8 + (idx & 7)];
            v = (lr < 16) ? (v * cs.x - pv * cs.y) : (pv * cs.y + v * cs.x);
          }
          stage_val(wl, ml, nt * 32 + lr, v);
        }
      }
#pragma unroll
    for (int nt = 0; nt < 2; ++nt) {
      const int nn = n0w + nt * 32;
      bf16* base = nullptr; int stride = 0;
      if (nn < 512) { base = (bf16*)(ws + OFF_QA) + (size_t)(nn >> 6) * NT * 64 + (nn & 63); stride = 64; }
      else if (nn < 1024) { base = (bf16*)(ws + OFF_KA) + (size_t)((nn - 512) >> 6) * NT * 64 + (nn & 63); stride = 64; }
      else if (nn < 2048) { base = (bf16*)(ws + OFF_G) + (nn - 1536); stride = 1024; }
      else if (nn < 2432) { base = (bf16*)(ws + OFF_QL) + (nn - 2048); stride = 384; }
      else if (nn < 2688) { base = (bf16*)(ws + OFF_KVL) + (nn - 2432); stride = 256; }
      else if (nn < 2720) { base = (bf16*)(ws + OFF_KM) + 64; stride = 96; }
      else if (nn < E_IN) { base = (bf16*)(ws + OFF_G) + 512 + (nn - 2720); stride = 1024; }
      if (!base) continue;
      base += (size_t)m0w * stride;
      flush_unit(wl, nt, lane, base, stride);
      if (nn >= 2688 && nn < 2720) {
#pragma unroll 1
        for (int hh = 1; hh < 8; ++hh) flush_unit(wl, nt, lane, base + (size_t)hh * NT * 96, stride);
      }
    }
    return;
  }
  if (MODE == EP_ODD_IN) {
    if (tr) {
#pragma unroll
      for (int mt = 0; mt < 2; ++mt)
#pragma unroll
        for (int nt = 0; nt < 2; ++nt) {
          const int nb = n0w - 1024 + nt * 32, m = m0w + mt * 32 + lr;
          bf16* dst = (bf16*)(ws + OFF_VAT) + (size_t)nb * NT + m;
#pragma unroll
          for (int i = 0; i < 16; ++i) dst[(size_t)crow(i, lh) * NT] = f2bf(acc[mt][nt][i]);
        }
      return;
    }
    if (n0w < 1024) {
      const float2* t64 = (const float2*)(ws + OFF_T64);
      const int hw = (n0w & 511) >> 6;
      bf16* base = (bf16*)(ws + (n0w < 512 ? OFF_QA : OFF_KA)) + (size_t)hw * NT * 64;
#pragma unroll
      for (int mt = 0; mt < 2; ++mt) {
#pragma unroll
        for (int i = 0; i < 16; ++i) {
          const int m = m0w + mt * 32 + crow(i, lh);
          float x1 = acc[mt][0][i], x2 = acc[mt][1][i];
          if (is_lat) {
            int t = m - NCTX, pos = (lr < 16) ? (t >> 6) : (t & 63);
            float2 cs = t64[pos * 16 + (lr & 15)];
            float y1 = x1 * cs.x - x2 * cs.y, y2 = x1 * cs.y + x2 * cs.x;
            x1 = y1; x2 = y2;
          }
          stage_val(wl, mt * 32 + crow(i, lh), lr, x1);
          stage_val(wl, mt * 32 + crow(i, lh), 32 + lr, x2);
        }
      }
      flush_unit(wl, 0, lane, base + (size_t)m0w * 64, 64);
      flush_unit(wl, 1, lane, base + (size_t)m0w * 64 + 32, 64);
      return;
    }
#pragma unroll
    for (int mt = 0; mt < 2; ++mt)
#pragma unroll
      for (int nt = 0; nt < 2; ++nt) {
#pragma unroll
        for (int i = 0; i < 16; ++i) stage_val(wl, mt * 32 + crow(i, lh), nt * 32 + lr, acc[mt][nt][i]);
      }
#pragma unroll
    for (int nt = 0; nt < 2; ++nt) {
      const int nn = n0w + nt * 32;
      bf16* base; int stride;
      if (nn < 2048) { base = (bf16*)(ws + OFF_G) + (nn - 1536); stride = 1024; }
      else if (nn < 2560) { base = (bf16*)(ws + OFF_QL) + (nn - 2048); stride = 512; }
      else { base = (bf16*)(ws + OFF_G) + 512 + (nn - 2560); stride = 1024; }
      flush_unit(wl, nt, lane, base + (size_t)m0w * stride, stride);
    }
    return;
  }
}

DI float xmax32(float x) { auto r = __builtin_amdgcn_permlane32_swap(__float_as_uint(x), __float_as_uint(x), false, false); return fmaxf(__uint_as_float(r[0]), __uint_as_float(r[1])); }
DI float xsum32(float x) { auto r = __builtin_amdgcn_permlane32_swap(__float_as_uint(x), __float_as_uint(x), false, false); return __uint_as_float(r[0]) + __uint_as_float(r[1]); }
template <int DQK, int DV, int NS, int MODE, int NQ>
DI void attn_item(const Params& p, unsigned char* smem, int layer, int qb, int head, int tid) {
  tid = launder(tid);
  constexpr int KS = DQK * 2 + 16;
  constexpr int VS = 136;
  constexpr int KCH = DQK / 8;
  constexpr int NKC = 64 * KCH / 256;
  constexpr int NVC = DV * 8 / 256;
  constexpr int NDT = DV / 32;
  constexpr int NKS = DQK / 16;
  constexpr int K_BYTES = 64 * KS;
  unsigned char* ws = p.ws;
  const int li = layer >> 1;
  const int lane = tid & 63, lr = lane & 31, lh = lane >> 5;
  const int wave = __builtin_amdgcn_readfirstlane(tid >> 6);
  const bool qctx = qb < 2;

  const bf16* Qp[NS]; const bf16* Kp[NS]; const bf16* VT;
  float c;
  if (MODE == 0) { Qp[0] = (const bf16*)(ws + OFF_QM) + (size_t)head * NT * 96; Kp[0] = (const bf16*)(ws + OFF_KM) + (size_t)head * NT * 96;
                   VT = (const bf16*)(ws + OFF_VMT) + (size_t)head * 64 * NT; c = 0.10206207261596577f * LOG2E; }
  else if (MODE == 1) { Qp[0] = (const bf16*)(ws + OFF_QA) + (size_t)head * NT * 64; Kp[0] = (const bf16*)(ws + OFF_KA) + (size_t)head * NT * 64;
                   VT = (const bf16*)(ws + OFF_VAT) + (size_t)head * 64 * NT; c = 0.125f * LOG2E; }
  else {
#pragma unroll
    for (int s = 0; s < NS; ++s) { Qp[s] = (const bf16*)(ws + OFF_QA) + (size_t)(head * 2 + s) * NT * 64; Kp[s] = (const bf16*)(ws + OFF_KA) + (size_t)(head * 2 + s) * NT * 64; }
    VT = (const bf16*)(ws + OFF_VAT) + (size_t)head * 128 * NT; c = 0.125f * LOG2E;
  }

  int ntiles, kr_lo = 0, r_w = 0, r0w = 0, qc = 0, c0 = 0;
  if (qctx) ntiles = 4;
  else if (MODE == 1) {
    const int lb = qb - 2, ra_ = 2 * lb, rb_ = 2 * lb + 1;
    int r0a = min(max(ra_ - 4, 0), 248), r0b = min(max(rb_ - 4, 0), 248);
    kr_lo = r0a; ntiles = 4 + (r0b + 8 - r0a);
    r_w = 2 * lb + (wave >> 1); r0w = min(max(r_w - 4, 0), 248);
    qc = (wave & 1) * 32 + lr; c0 = min(max(qc - 8, 0), 48);
  } else ntiles = NT / 64;

  float* rpb = (float*)(smem + NS * K_BYTES + DV * VS);
  if (MODE == 1) {
    __syncthreads();
    const float* src = p.in[I_RPB] + (size_t)(li * 8 + head) * 465;
    for (int i = tid; i < 465; i += 256) rpb[i] = src[i] * LOG2E;
  }

  int tq[NQ];
#pragma unroll
  for (int n = 0; n < NQ; ++n) tq[n] = (qb + n) * 128 + wave * 32 + lr;
  bf16x8 qf[NQ][NS][NKS];
#pragma unroll
  for (int n = 0; n < NQ; ++n)
#pragma unroll
    for (int s = 0; s < NS; ++s)
#pragma unroll
      for (int ks = 0; ks < NKS; ++ks) qf[n][s][ks] = *(const bf16x8*)(Qp[s] + (size_t)tq[n] * DQK + ks * 16 + lh * 8);

  f32x16 O[NQ][NS][NDT];
#pragma unroll
  for (int n = 0; n < NQ; ++n)
#pragma unroll
    for (int s = 0; s < NS; ++s)
#pragma unroll
      for (int d = 0; d < NDT; ++d)
#pragma unroll
        for (int i = 0; i < 16; ++i) O[n][s][d][i] = 0.f;
  float mrun[NQ][NS], lrun[NQ][NS];
#pragma unroll
  for (int n = 0; n < NQ; ++n)
#pragma unroll
    for (int s = 0; s < NS; ++s) { mrun[n][s] = -1e30f; lrun[n][s] = 0.f; }

  constexpr bool PF = (MODE != 2);
  u32x4 rk[NS][NKC], rv[NVC];
  auto tile_tok = [&](int it) -> int { return (MODE == 1 && !qctx && it >= 4) ? (NCTX + (kr_lo + it - 4) * 64) : it * 64; };
  auto gload = [&](int it) {
    const int t0 = tile_tok(it);
#pragma unroll
    for (int s = 0; s < NS; ++s)
#pragma unroll
      for (int i = 0; i < NKC; ++i) { int cidx = tid + 256 * i, row = cidx / KCH, cj = cidx % KCH; rk[s][i] = *(const u32x4*)(Kp[s] + (size_t)(t0 + row) * DQK + cj * 8); }
#pragma unroll
    for (int i = 0; i < NVC; ++i) { int cidx = tid + 256 * i, row = cidx >> 3, cj = cidx & 7; rv[i] = *(const u32x4*)(VT + (size_t)row * NT + t0 + cj * 8); }
  };
  if (PF) gload(0);

#pragma unroll 1
  for (int it = 0; it < ntiles; ++it) {
    __syncthreads();
    if (!PF) gload(it);
#pragma unroll
    for (int s = 0; s < NS; ++s)
#pragma unroll
      for (int i = 0; i < NKC; ++i) { int cidx = tid + 256 * i, row = cidx / KCH, cj = cidx % KCH; *(u32x4*)(smem + s * K_BYTES + row * KS + cj * 16) = rk[s][i]; }
#pragma unroll
    for (int i = 0; i < NVC; ++i) { int cidx = tid + 256 * i, row = cidx >> 3, cj = cidx & 7;
      u32x2* d = (u32x2*)(smem + NS * K_BYTES + row * VS + cj * 16); u32x2 d0 = {rv[i].x, rv[i].y}, d1 = {rv[i].z, rv[i].w}; d[0] = d0; d[1] = d1; }
    __syncthreads();
    if (PF && it + 1 < ntiles) gload(it + 1);

    bool active = true; int kr = 0;
    if (MODE == 1 && !qctx && it >= 4) { kr = kr_lo + it - 4; active = (kr >= r0w) && (kr < r0w + 8); }
    if (!active) continue;

#pragma unroll(MODE == 2 ? 1 : 2)
    for (int sub = 0; sub < 2; ++sub) {
      bf16x8 P[NQ][NS][2];
#pragma unroll
      for (int s = 0; s < NS; ++s) {
        f32x16 S[NQ];
#pragma unroll
        for (int n = 0; n < NQ; ++n)
#pragma unroll
          for (int i = 0; i < 16; ++i) S[n][i] = 0.f;
#pragma unroll
        for (int ks = 0; ks < NKS; ++ks) {
          bf16x8 kf = *(const bf16x8*)(smem + s * K_BYTES + (sub * 32 + lr) * KS + ks * 32 + lh * 16);
#pragma unroll
          for (int n = 0; n < NQ; ++n) S[n] = MFMA(kf, qf[n][s][ks], S[n]);
        }
#pragma unroll
        for (int n = 0; n < NQ; ++n) {
          float cc = c;
          if (MODE == 1) {
            cc = 1.f;
            if (!qctx && it >= 4) {
              const float* brow = rpb + (kr - r_w + 7) * 31;
#pragma unroll
              for (int i = 0; i < 16; ++i) {
                const int kc = sub * 32 + crow(i, lh);
                const bool valid = (kc >= c0) && (kc < c0 + 16);
                const int bi = min(max(kc - qc + 15, 0), 30);
                S[n][i] = valid ? (S[n][i] * c + brow[bi]) : -1e30f;
              }
            } else {
#pragma unroll
              for (int i = 0; i < 16; ++i) S[n][i] = S[n][i] * c;
            }
          }
          float mx = S[n][0];
#pragma unroll
          for (int i = 1; i < 16; ++i) mx = fmaxf(mx, S[n][i]);
          mx = xmax32(mx);
          const float mnew = fmaxf(mrun[n][s], mx);
          if (__any(mnew > mrun[n][s])) {
            const float alpha = __builtin_amdgcn_exp2f((mrun[n][s] - mnew) * cc);
            lrun[n][s] *= alpha;
#pragma unroll
            for (int d = 0; d < NDT; ++d)
#pragma unroll
              for (int i = 0; i < 16; ++i) O[n][s][d][i] *= alpha;
            mrun[n][s] = mnew;
          }
          const float mc = mrun[n][s] * cc;
          float ls0 = 0.f, ls1 = 0.f;
#pragma unroll
          for (int i = 0; i < 16; i += 2) { S[n][i] = __builtin_amdgcn_exp2f(S[n][i] * cc - mc); S[n][i + 1] = __builtin_amdgcn_exp2f(S[n][i + 1] * cc - mc); ls0 += S[n][i]; ls1 += S[n][i + 1]; }
          lrun[n][s] += ls0 + ls1;
#pragma unroll
          for (int s2 = 0; s2 < 2; ++s2) {
            u32x4 u = {pack2(S[n][8 * s2 + 0], S[n][8 * s2 + 1]), pack2(S[n][8 * s2 + 2], S[n][8 * s2 + 3]),
                       pack2(S[n][8 * s2 + 4], S[n][8 * s2 + 5]), pack2(S[n][8 * s2 + 6], S[n][8 * s2 + 7])};
            P[n][s][s2] = __builtin_bit_cast(bf16x8, u);
          }
        }
      }
#pragma unroll
      for (int d = 0; d < NDT; ++d)
#pragma unroll
        for (int s2 = 0; s2 < 2; ++s2) {
          const unsigned char* vp = smem + NS * K_BYTES + (d * 32 + lr) * VS + (sub * 32 + 16 * s2 + 4 * lh) * 2;
          u32x2 lo = *(const u32x2*)vp, hi = *(const u32x2*)(vp + 16);
          u32x4 u = {lo.x, lo.y, hi.x, hi.y};
          bf16x8 vf = __builtin_bit_cast(bf16x8, u);
#pragma unroll
          for (int n = 0; n < NQ; ++n)
#pragma unroll
            for (int s = 0; s < NS; ++s) O[n][s][d] = MFMA(vf, P[n][s][s2], O[n][s][d]);
        }
    }
  }

#pragma unroll
  for (int n = 0; n < NQ; ++n) {
    float inv[NS];
#pragma unroll
    for (int s = 0; s < NS; ++s) inv[s] = 1.f / xsum32(lrun[n][s]);
    bf16* yrow = (bf16*)(ws + OFF_HY) + (size_t)tq[n] * 1024;
    const bf16* grow = (const bf16*)(ws + OFF_G) + (size_t)tq[n] * 1024;
    if (MODE != 2) {
      const int col0 = (MODE == 0 ? 512 : 0) + head * 64;
#pragma unroll
      for (int d = 0; d < NDT; ++d)
#pragma unroll
        for (int g4 = 0; g4 < 4; ++g4) {
          const int col = col0 + d * 32 + 8 * g4 + 4 * lh;
          u32x2 gu = *(const u32x2*)(grow + col);
          float g0 = __uint_as_float(gu.x << 16), g1 = __uint_as_float(gu.x & 0xffff0000u), g2 = __uint_as_float(gu.y << 16), g3 = __uint_as_float(gu.y & 0xffff0000u);
          float y0 = O[n][0][d][4 * g4 + 0] * inv[0] * silu(g0), y1 = O[n][0][d][4 * g4 + 1] * inv[0] * silu(g1);
          float y2 = O[n][0][d][4 * g4 + 2] * inv[0] * silu(g2), y3 = O[n][0][d][4 * g4 + 3] * inv[0] * silu(g3);
          { u32x2 yo = {pack2(y0, y1), pack2(y2, y3)}; *(u32x2*)(yrow + col) = yo; }
        }
    } else {
      const float lam_init = __uint_as_float((unsigned)__builtin_amdgcn_readfirstlane((layer == 1) ? 0x3eb60549 : 0x3f0e59d5));
      float v1 = p.in[I_LQ1][li * 64 + lane] * p.in[I_LK1][li * 64 + lane];
      float v2 = p.in[I_LQ2][li * 64 + lane] * p.in[I_LK2][li * 64 + lane];
      v1 = wave_sum(v1); v2 = wave_sum(v2);
      const float lam = __expf(v1) - __expf(v2) + lam_init;
      float ss = 0.f;
#pragma unroll
      for (int d = 0; d < NDT; ++d)
#pragma unroll
        for (int i = 0; i < 16; ++i) { float o = O[n][0][d][i] * inv[0] - lam * (O[n][NS - 1][d][i] * inv[NS - 1]); O[n][0][d][i] = o; ss += o * o; }
      ss = xsum32(ss);
      const float rstd = rsqrtf(ss * (1.f / 128.f) + EPS) * (1.f - lam_init);
      const float* sub = p.in[I_SUBLN] + li * 128;
      const int col0 = head * 128;
#pragma unroll
      for (int d = 0; d < NDT; ++d)
#pragma unroll
        for (int g4 = 0; g4 < 4; ++g4) {
          const int dd = d * 32 + 8 * g4 + 4 * lh, col = col0 + dd;
          u32x2 gu = *(const u32x2*)(grow + col);
          float g0 = __uint_as_float(gu.x << 16), g1 = __uint_as_float(gu.x & 0xffff0000u), g2 = __uint_as_float(gu.y << 16), g3 = __uint_as_float(gu.y & 0xffff0000u);
          float4 sl = *(const float4*)(sub + dd);
          float y0 = O[n][0][d][4 * g4 + 0] * rstd * sl.x * silu(g0), y1 = O[n][0][d][4 * g4 + 1] * rstd * sl.y * silu(g1);
          float y2 = O[n][0][d][4 * g4 + 2] * rstd * sl.z * silu(g2), y3 = O[n][0][d][4 * g4 + 3] * rstd * sl.w * silu(g3);
          { u32x2 yo = {pack2(y0, y1), pack2(y2, y3)}; *(u32x2*)(yrow + col) = yo; }
        }
    }
  }
}

template <bool PASS2>
DI void lru_item(const Params& p, unsigned char* smem, int layer, int chunk, int g, int tid) {
  tid = launder(tid);
  const int oi = layer >> 1;
  unsigned char* ws = p.ws;
  float* us = (float*)smem;
  unsigned char* ubf = smem + 16384;
  float2* ab = (float2*)(smem + 25600);
  float2* seg = (float2*)(smem + 58368);
  float2* seg2 = seg + 256;
  const int j = tid & 63, tg = tid >> 6, ch = g * 64 + j;
  const int t0 = chunk * 64;
  const int seq_lo = chunk < 4 ? 0 : NCTX, seq_hi = chunk < 4 ? NCTX : NT;
  const bf16* lx = (const bf16*)(ws + OFF_QL);
  __syncthreads();
  if (PASS2) {
    const float2* carp = (const float2*)(ws + OFF_CAR);
#pragma unroll
    for (int d = 0; d < 2; ++d) {
      const int npre = (d == 0) ? chunk : (chunk < 4 ? 3 - chunk : 4 + (NCHUNK - 1 - chunk));
      const int i0 = (npre * tg) >> 2, i1 = (npre * (tg + 1)) >> 2;
      float2 cv[65];
#pragma unroll
      for (int q = 0; q < 65; ++q) {
        const int idx = i0 + q;
        const int cc = (d == 0) ? idx : (idx < 4 ? 3 - idx : NCHUNK + 3 - idx);
        cv[q] = make_float2(1.f, 0.f);
        if (idx < i1) cv[q] = carp[(size_t)(cc * 2 + d) * 512 + ch];
      }
      float A = 1.f, B = 0.f;
#pragma unroll
      for (int q = 0; q < 65; ++q) { B = cv[q].x * B + cv[q].y; A *= cv[q].x; }
      seg2[(d * 4 + tg) * 64 + j] = make_float2(A, B);
    }
  }
  {
    const float* cw = p.in[I_CONVW] + (size_t)oi * 4 * 512;
    const float w0 = cw[ch], w1 = cw[512 + ch], w2 = cw[1024 + ch], w3 = cw[1536 + ch], cb = p.in[I_CONVB][oi * 512 + ch];
    float xv[19];
#pragma unroll
    for (int i = 0; i < 19; ++i) { int t = t0 + tg * 16 - 2 + i; xv[i] = (t >= seq_lo && t < seq_hi) ? bf2f(lx[(size_t)t * 512 + ch]) : 0.f; }
#pragma unroll
    for (int tt = 0; tt < 16; ++tt) {
      const float uv = cb + xv[tt] * w0 + xv[tt + 1] * w1 + xv[tt + 2] * w2 + xv[tt + 3] * w3;
      us[(tg * 16 + tt) * 64 + j] = uv;
      *(bf16*)(ubf + (tg * 16 + tt) * 144 + j * 2) = f2bf(uv);
    }
  }
  float hs[16];
#pragma unroll
  for (int i = 0; i < 16; ++i) hs[i] = 0.f;
  float2* car = (float2*)(ws + OFF_CAR);

#pragma unroll 1
  for (int d = 0; d < 2; ++d) {
    __syncthreads();
    {
      const int wave = __builtin_amdgcn_readfirstlane(tid >> 6);
      const int lane = tid & 63, lr = lane & 31, lh = lane >> 5;
      const int mt = wave >> 1, nt = wave & 1;
      const bf16* wt = (const bf16*)(ws + OFF_LW) + (size_t)(((oi * 2 + d) * 8 + g) * 2) * 4096 + (nt * 32 + lr) * 64 + lh * 8;
      f32x16 ca, cx;
#pragma unroll
      for (int i = 0; i < 16; ++i) { ca[i] = 0.f; cx[i] = 0.f; }
#pragma unroll
      for (int ks = 0; ks < 4; ++ks) {
        const bf16x8 af = *(const bf16x8*)(ubf + (mt * 32 + lr) * 144 + ks * 32 + lh * 16);
        const bf16x8 ba_ = *(const bf16x8*)(wt + ks * 16);
        const bf16x8 bx_ = *(const bf16x8*)(wt + 4096 + ks * 16);
        ca = MFMA(af, ba_, ca);
        cx = MFMA(af, bx_, cx);
      }
      const int cj = nt * 32 + lr, chj = g * 64 + cj;
      const float ba = p.in[I_BA][(oi * 2 + d) * 512 + chj], bx = p.in[I_BX][(oi * 2 + d) * 512 + chj];
      const float sp = log1pf(__expf(-p.in[I_LAMBDA][(oi * 2 + d) * 512 + chj]));
#pragma unroll
      for (int i = 0; i < 16; ++i) {
        const int t = mt * 32 + crow(i, lh);
        const float r = sigm(ca[i] + ba), ig = sigm(cx[i] + bx);
        const float a = __expf(-8.f * r * sp);
        const float b = __builtin_amdgcn_sqrtf(fmaxf(1.f - a * a, 0.f)) * (ig * us[t * 64 + cj]);
        ab[t * 64 + cj] = make_float2(a, b);
      }
    }
    __syncthreads();
    float ar[16], ai[16];
    float Ap = 1.f, Bp = 0.f;
#pragma unroll
    for (int q = 0; q < 16; ++q) {
      const int tt = d ? 15 - q : q;
      const float2 v = ab[(tg * 16 + tt) * 64 + j];
      ar[tt] = v.x; ai[tt] = v.y;
      Bp = v.x * Bp + v.y; Ap *= v.x;
    }
    seg[tg * 64 + j] = make_float2(Ap, Bp);
    __syncthreads();
    if (!PASS2) {
      if (tg == 0) {
        float A = 1.f, B = 0.f;
#pragma unroll
        for (int q = 0; q < 4; ++q) { float2 sg = seg[(d ? 3 - q : q) * 64 + j]; B = sg.x * B + sg.y; A *= sg.x; }
        car[(size_t)(chunk * 2 + d) * 512 + ch] = make_float2(A, B);
      }
    } else {
      float h = 0.f;
#pragma unroll
      for (int q = 0; q < 4; ++q) { float2 sg = seg2[(d * 4 + q) * 64 + j]; h = sg.x * h + sg.y; }
      if (d == 0) {
        for (int q = 0; q < tg; ++q) { float2 sg = seg[q * 64 + j]; h = sg.x * h + sg.y; }
#pragma unroll
        for (int tt = 0; tt < 16; ++tt) { h = ar[tt] * h + ai[tt]; hs[tt] += h; }
      } else {
        for (int q = 3; q > tg; --q) { float2 sg = seg[q * 64 + j]; h = sg.x * h + sg.y; }
#pragma unroll
        for (int tt = 15; tt >= 0; --tt) { h = ar[tt] * h + ai[tt]; hs[tt] += h; }
      }
    }
  }
  if (PASS2) {
    const bf16* G = (const bf16*)(ws + OFF_G);
    bf16* Y = (bf16*)(ws + OFF_HY);
#pragma unroll
    for (int tt = 0; tt < 16; ++tt) {
      const size_t o = (size_t)(t0 + tg * 16 + tt) * 1024 + 512 + ch;
      Y[o] = f2bf(hs[tt] * silu(bf2f(G[o])));
    }
  }
}


DI void grid_barrier(unsigned* bar, unsigned k, unsigned nb) {
  asm volatile("s_waitcnt vmcnt(0) lgkmcnt(0)" ::: "memory");
  __syncthreads();
  if (threadIdx.x == 0) {
    __builtin_amdgcn_fence(__ATOMIC_RELEASE, "agent");
    asm volatile("s_waitcnt vmcnt(0)" ::: "memory");
    const unsigned g = blockIdx.x & 7u;
    const unsigned ngroups = nb < 8u ? nb : 8u;
    const unsigned gsize = (nb - g + 7u) >> 3;
    const unsigned old = __hip_atomic_fetch_add(bar + 128 + 32 * g, 1u, __ATOMIC_RELAXED, __HIP_MEMORY_SCOPE_AGENT);
    if (old == gsize * k - 1u) {
      const unsigned old2 = __hip_atomic_fetch_add(bar, 1u, __ATOMIC_RELAXED, __HIP_MEMORY_SCOPE_AGENT);
      if (old2 == ngroups * k - 1u) __hip_atomic_store(bar + 64, k, __ATOMIC_RELAXED, __HIP_MEMORY_SCOPE_AGENT);
    }
    while (__hip_atomic_load(bar + 64, __ATOMIC_RELAXED, __HIP_MEMORY_SCOPE_AGENT) < k) __builtin_amdgcn_s_sleep(1);
    __builtin_amdgcn_fence(__ATOMIC_ACQUIRE, "agent");
    asm volatile("s_waitcnt vmcnt(0)" ::: "memory");
  }
  __syncthreads();
}

DI int grab_item(unsigned* ctr, int base, int wv, int* slot) {
  const int t = launder(wv);
  __syncthreads();
  if (t == 0) *slot = base + (int)__hip_atomic_fetch_add(ctr, 1u, __ATOMIC_RELAXED, __HIP_MEMORY_SCOPE_AGENT);
  __syncthreads();
  return __builtin_amdgcn_readfirstlane(*slot);
}

constexpr int N_PHASES = 22;

__global__ void __launch_bounds__(256, 2) mega(Params p, int ph_lo, int ph_hi) {
  __shared__ __attribute__((aligned(16))) unsigned char smem[LDS_BYTES];
  __shared__ int s_item;
  const int tid = __builtin_amdgcn_readfirstlane(threadIdx.x >> 6);
  const int nb = gridDim.x;
  if ((int)blockIdx.x >= (nb >> 1)) __builtin_amdgcn_s_setprio(1);
#pragma unroll 1
  for (int ph = ph_lo; ph < ph_hi; ++ph) {
    if (ph > ph_lo) {
      if (ph_hi < 0) cg::this_grid().sync();
      grid_barrier((unsigned*)(p.ws + OFF_BAR), (unsigned)(ph - ph_lo), (unsigned)nb);
    }
    if (ph == 0) {
      constexpr int n_items = 192 + 64 + 24 + N_WEARLY;
      unsigned* ctr0 = (unsigned*)(p.ws + OFF_BAR) + 32;
      for (int it = blockIdx.x; it < n_items; it = grab_item(ctr0, nb, tid, &s_item)) {
        if (it < 192) prep_mod(p, smem, it, tid);
        else if (it < 256) prep_lruw(p, smem, it - 192, tid);
        else if (it < 280) prep_tab(p, it - 256, tid);
        else prep_wtile(p, smem, it - 280, tid);
      }
      continue;
    }
    if (ph == N_PHASES - 1) {
      for (int it = blockIdx.x; it < 4096; it += nb) final_rows(p, it, tid);
      continue;
    }
    const int layer = (ph - 1) / 5, sub = (ph - 1) % 5;
    const bool odd = layer & 1;
    unsigned* ctr = (unsigned*)(p.ws + OFF_BAR) + 32 + ph;
#define NEXT_ITEM grab_item(ctr, nb, tid, &s_item)
    if (sub == 0) {
      for (int it = blockIdx.x; it < NT / 4; it += nb) norm_rows(p, layer, it, tid);
    } else if (sub == 1) {
      if (!odd) { for (int it = blockIdx.x; it < 130 * 26; it = NEXT_ITEM) gemm_tile<EP_EVEN_IN>(p, smem, layer, it / 26, it % 26, tid); }
      else { for (int it = blockIdx.x; it < 130 * 24; it = NEXT_ITEM) gemm_tile<EP_ODD_IN>(p, smem, layer, it / 24, it % 24, tid); }
    } else if (sub == 2) {
      if (!odd) {
        for (int it = blockIdx.x; it < 130 * 14; it = NEXT_ITEM) {
          const int mt = it / 14, nt = it % 14;
          if (nt < 6) gemm_tile<EP_UPQ>(p, smem, layer, mt, nt, tid);
          else gemm_tile<EP_UPKV>(p, smem, layer, mt, nt - 6, tid);
        }
      } else {
        for (int it = blockIdx.x; it < NCHUNK * 8; it = NEXT_ITEM) lru_item<false>(p, smem, layer, it >> 3, it & 7, tid);
      }
    } else if (sub == 3) {
      if (!odd) {
        const int n_fill = (layer == 0) ? (N_WTILES - N_WEARLY) : 0;
        for (int it = blockIdx.x; it < 520 + 1040 + n_fill; it = NEXT_ITEM) {
          if (it >= 1560) { prep_wtile(p, smem, N_WEARLY + it - 1560, tid); continue; }
          if (it < 520) {
            const int head = it & 7, pi = it >> 3;
            const int qb = pi < 64 ? 2 + 2 * pi : 0;
            attn_item<96, 64, 1, 0, 2>(p, smem, layer, qb, head, tid);
          } else {
            const int idx = it - 520;
            const int head = idx & 7, qbi = idx >> 3;
            const int qb = qbi < 128 ? qbi + 2 : qbi - 128;
            attn_item<64, 64, 1, 1, 1>(p, smem, layer, qb, head, tid);
          }
        }
      } else {
        for (int it = blockIdx.x; it < 520 + NCHUNK * 8; it = NEXT_ITEM) {
          if (it < 520) {
            const int head = it & 3, qbi = it >> 2;
            const int qb = qbi < 128 ? qbi + 2 : qbi - 128;
#ifndef NO_DIFF
            attn_item<64, 128, 2, 2, 1>(p, smem, layer, qb, head, tid);
#endif
          } else {
            const int k = it - 520;
#ifndef NO_LRU
            lru_item<true>(p, smem, layer, k >> 3, k & 7, tid);
#endif
          }
        }
      }
    } else {
      const int skip = (layer == 3) ? 16 : 0;
      for (int it = blockIdx.x; it < 130 * 8 - skip; it = NEXT_ITEM) gemm_tile<EP_OUT>(p, smem, layer, (it + skip) >> 3, (it + skip) & 7, tid);
    }
  }
}

extern "C" void kernel_launch(void* const* d_in, const int* in_sizes, int n_in, void* d_out, int out_size, void* d_ws, size_t ws_size,
                              hipStream_t stream) {
  static int grid_blocks = 0;
  if (!grid_blocks) {
    int dev = 0, cus = 0, per_cu = 0;
    hipGetDevice(&dev);
    hipDeviceGetAttribute(&cus, hipDeviceAttributeMultiprocessorCount, dev);
    hipOccupancyMaxActiveBlocksPerMultiprocessor(&per_cu, mega, 256, 0);
    if (per_cu < 1) per_cu = 1;
    if (per_cu > 2) per_cu = 2;
    grid_blocks = cus * per_cu;
    if (ws_size < WS_END) fprintf(stderr, "kernel_launch: workspace too small (%zu < %zu)\n", ws_size, (size_t)WS_END);
  }
  Params p{};
  for (int i = 0; i < 29; ++i) p.in[i] = (const float*)d_in[i];
  p.out = (float*)d_out; p.ws = (unsigned char*)d_ws;
#if COOP
  hipMemsetAsync((unsigned char*)d_ws + OFF_BAR, 0, 2048, stream);
  int lo = 0, hi = N_PHASES;
  void* args[] = {&p, &lo, &hi};
  hipError_t e = hipLaunchCooperativeKernel((void*)mega, dim3(grid_blocks), dim3(256), args, 0, stream);
  if (e != hipSuccess) fprintf(stderr, "cooperative launch failed: %s (grid %d)\n", hipGetErrorString(e), grid_blocks);
#else
  for (int ph = 0; ph < N_PHASES; ++ph) hipLaunchKernelGGL(mega, dim3(grid_blocks), dim3(256), 0, stream, p, ph, ph + 1);
#endif
}
```

```cpp
#include <hip/hip_runtime.h>
#include <hip/hip_cooperative_groups.h>
#include <cstdio>
namespace cg = cooperative_groups;

#ifndef COOP
#define COOP 1
#endif

#define DI __device__ __forceinline__
typedef unsigned short bf16;
using bf16x8 = __attribute__((ext_vector_type(8))) short;
using f32x16 = __attribute__((ext_vector_type(16))) float;
typedef __bf16 v2bf __attribute__((ext_vector_type(2)));
typedef float v2f __attribute__((ext_vector_type(2)));
typedef unsigned u32x4 __attribute__((ext_vector_type(4)));
typedef unsigned u32x2 __attribute__((ext_vector_type(2)));
#define MFMA(a, b, c) __builtin_amdgcn_mfma_f32_32x32x16_bf16((a), (b), (c), 0, 0, 0)

constexpr int NT = 16640;
constexpr int NCTX = 256;
constexpr int E_IN = 3232, E_INP = 3328, O_IN = 3072;
constexpr float EPS = 1e-6f;
constexpr float LOG2E = 1.4426950408889634f;
constexpr int NCHUNK = 260;

constexpr size_t al(size_t x) { return (x + 255) & ~size_t(255); }
constexpr size_t OFF_XC   = 0;
constexpr size_t OFF_MOD  = OFF_XC + al(256 * 1024 * 4);
constexpr size_t OFF_T64  = OFF_MOD + al(4 * 2 * 3072 * 4);
constexpr size_t OFF_T32  = OFF_T64 + al(256 * 16 * 8);
constexpr size_t OFF_CAR  = OFF_T32 + al(256 * 8 * 8);
constexpr size_t SZ_WEIN  = (size_t)E_INP * 1024 * 2;
constexpr size_t SZ_WOUT  = (size_t)1024 * 1024 * 2;
constexpr size_t SZ_WUQ   = (size_t)768 * 384 * 2;
constexpr size_t SZ_WUKV  = (size_t)1024 * 256 * 2;
constexpr size_t SZ_WOIN  = (size_t)O_IN * 1024 * 2;
constexpr size_t OFF_WEIN = OFF_CAR + al(NCHUNK * 2 * 512 * 8);
constexpr size_t OFF_WEOUT = OFF_WEIN + 2 * SZ_WEIN;
constexpr size_t OFF_WUQ  = OFF_WEOUT + 2 * SZ_WOUT;
constexpr size_t OFF_WUKV = OFF_WUQ + 2 * SZ_WUQ;
constexpr size_t OFF_WOIN = OFF_WUKV + 2 * SZ_WUKV;
constexpr size_t OFF_WOOUT = OFF_WOIN + 2 * SZ_WOIN;
constexpr size_t OFF_HY   = OFF_WOOUT + 2 * SZ_WOUT;
constexpr size_t OFF_G    = OFF_HY + (size_t)NT * 1024 * 2;
constexpr size_t SZ_H64   = (size_t)8 * NT * 64 * 2;
constexpr size_t OFF_QA   = OFF_G + (size_t)NT * 1024 * 2;
constexpr size_t OFF_KA   = OFF_QA + SZ_H64;
constexpr size_t OFF_VAT  = OFF_KA + SZ_H64;
constexpr size_t OFF_QL   = OFF_VAT + SZ_H64;
constexpr size_t OFF_KVL  = OFF_QL + (size_t)NT * 384 * 2;
constexpr size_t OFF_QM   = OFF_KVL + (size_t)NT * 256 * 2;
constexpr size_t OFF_KM   = OFF_QM + (size_t)8 * NT * 96 * 2;
constexpr size_t OFF_VMT  = OFF_KM + (size_t)8 * NT * 96 * 2;
constexpr size_t OFF_BAR  = OFF_VMT + SZ_H64;
constexpr size_t OFF_LW   = OFF_BAR + 2048;
constexpr size_t WS_END   = OFF_LW + (size_t)64 * 4096 * 2;
static_assert(WS_END <= (size_t)256 * 1024 * 1024, "workspace too large");

constexpr int LDS_BYTES = 63 * 1024;

struct Params { const float* in[29]; float* out; unsigned char* ws; };

enum { I_X = 0, I_C, I_CTX, I_CCTX, I_MODW, I_MODB, I_NORMG, I_FINALG, I_EWIN, I_EWOUT, I_RPB, I_QNORM, I_WUQ, I_KVNORM, I_WUKV,
       I_OWIN, I_OWOUT, I_LQ1, I_LK1, I_LQ2, I_LK2, I_SUBLN, I_CONVW, I_CONVB, I_LAMBDA, I_WA, I_BA, I_WX, I_BX };

DI float bf2f(bf16 u) { return __uint_as_float(((unsigned)u) << 16); }
DI unsigned pack2(float a, float b) { v2f x = {a, b}; v2bf r = __builtin_convertvector(x, v2bf); return __builtin_bit_cast(unsigned, r); }
DI bf16 f2bf(float x) { return (bf16)pack2(x, x); }
DI int crow(int i, int h) { return (i & 3) + 8 * (i >> 2) + 4 * h; }
DI float sigm(float x) { return __builtin_amdgcn_rcpf(1.f + __expf(-x)); }
DI float silu(float x) { return x * sigm(x); }
DI float wave_sum(float v) {
#pragma unroll
  for (int o = 32; o > 0; o >>= 1) v += __shfl_xor(v, o);
  return v;
}
DI int launder(int wv) { int l; asm volatile("v_mbcnt_lo_u32_b32 %0, -1, 0\n\tv_mbcnt_hi_u32_b32 %0, -1, %0" : "=v"(l)); return (wv << 6) + l; }
DI float* xrow(const Params& p, int row) {
  return row < NCTX ? (float*)(p.ws + OFF_XC) + (size_t)row * 1024 : p.out + (size_t)(row - NCTX) * 1024;
}

DI const float* xrow_in(const Params& p, int row) {
  return row < NCTX ? p.in[I_CTX] + (size_t)row * 1024 : p.in[I_X] + (size_t)(row - NCTX) * 1024;
}

DI void prep_wtile(const Params& p, unsigned char* smem, int item, int tid) {
  tid = launder(tid);
  int lay = 0, kind = 0, K = 0, N = 0, NP = 0; const float* src = nullptr; const float* gv = nullptr; bf16* dst = nullptr;
  int rem = item;
  const unsigned long long order = 0xBA9875312640ull;
#pragma unroll 1
  for (int q = 0; q < 12; ++q) {
    const int d = (int)((order >> (4 * q)) & 15ull);
    kind = d >> 1; lay = d & 1;
    switch (kind) {
      case 0: K = 1024; N = E_IN; NP = E_INP; break;
      case 1: K = 1024; N = 1024; NP = 1024; break;
      case 2: K = 384; N = 768; NP = 768; break;
      case 3: K = 256; N = 1024; NP = 1024; break;
      case 4: K = 1024; N = O_IN; NP = O_IN; break;
      default: K = 1024; N = 1024; NP = 1024; break;
    }
    int nt = (K >> 6) * (NP >> 6);
    if (rem < nt) break;
    rem -= nt;
  }
  switch (kind) {
    case 0: src = p.in[I_EWIN] + (size_t)lay * 1024 * E_IN; dst = (bf16*)(p.ws + OFF_WEIN + lay * SZ_WEIN); break;
    case 1: src = p.in[I_EWOUT] + (size_t)lay * 1024 * 1024; dst = (bf16*)(p.ws + OFF_WEOUT + lay * SZ_WOUT); break;
    case 2: src = p.in[I_WUQ] + (size_t)lay * 384 * 768; dst = (bf16*)(p.ws + OFF_WUQ + lay * SZ_WUQ); gv = p.in[I_QNORM] + lay * 384; break;
    case 3: src = p.in[I_WUKV] + (size_t)lay * 256 * 1024; dst = (bf16*)(p.ws + OFF_WUKV + lay * SZ_WUKV); gv = p.in[I_KVNORM] + lay * 256; break;
    case 4: src = p.in[I_OWIN] + (size_t)lay * 1024 * O_IN; dst = (bf16*)(p.ws + OFF_WOIN + lay * SZ_WOIN); break;
    default: src = p.in[I_OWOUT] + (size_t)lay * 1024 * 1024; dst = (bf16*)(p.ws + OFF_WOOUT + lay * SZ_WOUT); break;
  }
  const int ktiles = K >> 6;
  const int k0 = (rem % ktiles) * 64, n0 = (rem / ktiles) * 64;
  float* t = (float*)smem;
  __syncthreads();
#pragma unroll
  for (int i = 0; i < 16; ++i) {
    int k = i * 4 + (tid >> 6), n = tid & 63;
    float v = 0.f;
    if (n0 + n < N) { v = src[(size_t)(k0 + k) * N + n0 + n]; if (gv) v *= gv[k0 + k]; }
    t[k * 65 + n] = v;
  }
  __syncthreads();
#pragma unroll
  for (int i = 0; i < 16; ++i) {
    int n = i * 4 + (tid >> 6), k = tid & 63;
    dst[(size_t)(n0 + n) * K + k0 + k] = f2bf(t[k * 65 + n]);
  }
}
constexpr int N_WTILES = 2 * (16 * 52 + 256 + 6 * 12 + 4 * 16 + 16 * 48 + 256);
constexpr int N_WEARLY = 16 * 52 + 6 * 12 + 4 * 16 + 256;

DI void prep_lruw(const Params& p, unsigned char* smem, int item, int tid) {
  tid = launder(tid);
  const int which = item & 1, m = item >> 1;
  const float* src = (which ? p.in[I_WX] : p.in[I_WA]) + (size_t)m * 4096;
  bf16* dst = (bf16*)(p.ws + OFF_LW) + (size_t)item * 4096;
  float* t = (float*)smem;
  __syncthreads();
#pragma unroll
  for (int i = 0; i < 16; ++i) { int k = i * 4 + (tid >> 6), n = tid & 63; t[k * 65 + n] = src[k * 64 + n]; }
  __syncthreads();
#pragma unroll
  for (int i = 0; i < 16; ++i) { int n = i * 4 + (tid >> 6), k = tid & 63; dst[n * 64 + k] = f2bf(t[k * 65 + n]); }
}


DI void prep_mod(const Params& p, unsigned char* smem, int item, int tid) {
  tid = launder(tid);
  const int l = item / 48, cb = item % 48;
  const int col = cb * 64 + (tid & 63), kg = tid >> 6;
  const float* w = p.in[I_MODW] + (size_t)l * 1024 * 3072;
  float* sv = (float*)smem + 512;
  __syncthreads();
#pragma unroll
  for (int i = 0; i < 4; ++i) { int k = tid + 256 * i; sv[k] = silu(p.in[I_C][k]); sv[1024 + k] = silu(p.in[I_CCTX][k]); }
  __syncthreads();
  float aL = 0.f, aC = 0.f;
#pragma unroll 16
  for (int k = kg * 256; k < kg * 256 + 256; ++k) {
    float wv = w[(size_t)k * 3072 + col];
    aL += sv[k] * wv;
    aC += sv[1024 + k] * wv;
  }
  float* t = (float*)smem;
  __syncthreads();
  t[tid] = aL; t[256 + tid] = aC;
  __syncthreads();
  if (tid < 64) {
    float b = p.in[I_MODB][l * 3072 + col];
    float sL = t[tid] + t[64 + tid] + t[128 + tid] + t[192 + tid] + b;
    float sC = t[256 + tid] + t[320 + tid] + t[384 + tid] + t[448 + tid] + b;
    float* mod = (float*)(p.ws + OFF_MOD);
    mod[(l * 2 + 0) * 3072 + col] = sL;
    mod[(l * 2 + 1) * 3072 + col] = sC;
  }
}

DI void prep_tab(const Params& p, int item, int tid) {
  tid = launder(tid);
  int e = item * 256 + tid;
  if (e < 4096) {
    int pos = e >> 4, f = e & 15;
    float inv = powf(10000.f, -(float)f / 16.f);
    float a = (float)pos * inv, s, c; sincosf(a, &s, &c);
    ((float2*)(p.ws + OFF_T64))[e] = make_float2(c, s);
  } else {
    e -= 4096;
    int pos = e >> 3, f = e & 7;
    float inv = powf(10000.f, -(float)f / 8.f);
    float a = (float)pos * inv, s, c; sincosf(a, &s, &c);
    ((float2*)(p.ws + OFF_T32))[e] = make_float2(c, s);
  }
}

DI void prep_copy(const Params& p, int item, int tid) {
  tid = launder(tid);
#pragma unroll 4
  for (int i = 0; i < 16; ++i) {
    int row = item * 16 + i;
    const float* s = row < NCTX ? p.in[I_CTX] + (size_t)row * 1024 : p.in[I_X] + (size_t)(row - NCTX) * 1024;
    ((float4*)xrow(p, row))[tid] = ((const float4*)s)[tid];
  }
}

DI void norm_rows(const Params& p, int l, int item, int tid) {
  tid = launder(tid);
  const int row = item * 4 + (tid >> 6), lane = tid & 63;
  const float* x = (l == 0) ? xrow_in(p, row) : (const float*)xrow(p, row);
  float4 v[4]; float ss = 0.f;
#pragma unroll
  for (int i = 0; i < 4; ++i) { v[i] = ((const float4*)x)[i * 64 + lane]; ss += v[i].x * v[i].x + v[i].y * v[i].y + v[i].z * v[i].z + v[i].w * v[i].w; }
  ss = wave_sum(ss);
  const float rstd = rsqrtf(ss * (1.f / 1024.f) + EPS);
  const float* mod = (const float*)(p.ws + OFF_MOD) + (l * 2 + (row < NCTX ? 1 : 0)) * 3072;
  const float* g = p.in[I_NORMG] + l * 1024;
  bf16* h = (bf16*)(p.ws + OFF_HY) + (size_t)row * 1024;
#pragma unroll
  for (int i = 0; i < 4; ++i) {
    int k = (i * 64 + lane) * 4;
    float4 gg = *(const float4*)(g + k), sh = *(const float4*)(mod + k), sc = *(const float4*)(mod + 1024 + k);
    float a = v[i].x * rstd * gg.x * (1.f + sc.x) + sh.x;
    float b = v[i].y * rstd * gg.y * (1.f + sc.y) + sh.y;
    float c = v[i].z * rstd * gg.z * (1.f + sc.z) + sh.z;
    float d = v[i].w * rstd * gg.w * (1.f + sc.w) + sh.w;
    u32x2 o = {pack2(a, b), pack2(c, d)};
    *(u32x2*)(h + k) = o;
  }
}

DI void final_rows(const Params& p, int item, int tid) {
  tid = launder(tid);
  const int row = item * 4 + (tid >> 6), lane = tid & 63;
  float* x = p.out + (size_t)row * 1024;
  float4 v[4]; float ss = 0.f;
#pragma unroll
  for (int i = 0; i < 4; ++i) { v[i] = ((const float4*)x)[i * 64 + lane]; ss += v[i].x * v[i].x + v[i].y * v[i].y + v[i].z * v[i].z + v[i].w * v[i].w; }
  ss = wave_sum(ss);
  const float rstd = rsqrtf(ss * (1.f / 1024.f) + EPS);
  const float* g = p.in[I_FINALG];
#pragma unroll
  for (int i = 0; i < 4; ++i) {
    int k = (i * 64 + lane) * 4;
    float4 gg = *(const float4*)(g + k);
    float4 o = make_float4(v[i].x * rstd * gg.x, v[i].y * rstd * gg.y, v[i].z * rstd * gg.z, v[i].w * rstd * gg.w);
    *(float4*)(x + k) = o;
  }
}

template <bool TR>
DI void gemm_k(const bf16* __restrict__ A, int lda, const bf16* __restrict__ B, int ldb, int K, unsigned char* smem,
               f32x16 (&acc)[2][2], int tid, int lane, int wm, int wn) {
  const int lr = lane & 31, lh = lane >> 5;
  u32x4 ra[4], rb[4];
#pragma unroll
  for (int i = 0; i < 4; ++i) {
    int c = tid + 256 * i, row = c >> 3, cj = c & 7;
    ra[i] = *(const u32x4*)(A + (size_t)row * lda + cj * 8);
    rb[i] = *(const u32x4*)(B + (size_t)row * ldb + cj * 8);
  }
#pragma unroll 1
  for (int k0 = 0; k0 < K; k0 += 64) {
    __syncthreads();
#pragma unroll
    for (int i = 0; i < 4; ++i) {
      int c = tid + 256 * i, row = c >> 3, cj = c & 7;
      *(u32x4*)(smem + row * 144 + cj * 16) = ra[i];
      *(u32x4*)(smem + 18432 + row * 144 + cj * 16) = rb[i];
    }
    __syncthreads();
    if (k0 + 64 < K) {
#pragma unroll
      for (int i = 0; i < 4; ++i) {
        int c = tid + 256 * i, row = c >> 3, cj = c & 7;
        ra[i] = *(const u32x4*)(A + (size_t)row * lda + k0 + 64 + cj * 8);
        rb[i] = *(const u32x4*)(B + (size_t)row * ldb + k0 + 64 + cj * 8);
      }
    }
#pragma unroll
    for (int ks = 0; ks < 4; ++ks) {
      bf16x8 af[2], bfr[2];
#pragma unroll
      for (int t = 0; t < 2; ++t) {
        af[t] = *(const bf16x8*)(smem + (wm * 64 + t * 32 + lr) * 144 + ks * 32 + lh * 16);
        bfr[t] = *(const bf16x8*)(smem + 18432 + (wn * 64 + t * 32 + lr) * 144 + ks * 32 + lh * 16);
      }
#pragma unroll
      for (int mt = 0; mt < 2; ++mt)
#pragma unroll
        for (int nt = 0; nt < 2; ++nt)
          acc[mt][nt] = TR ? MFMA(bfr[nt], af[mt], acc[mt][nt]) : MFMA(af[mt], bfr[nt], acc[mt][nt]);
    }
  }
}

enum { EP_EVEN_IN = 0, EP_UPQ, EP_UPKV, EP_ODD_IN, EP_OUT };

DI void st_tile_rm(bf16* base, size_t row_stride, int m0, int lh, const f32x16& a, float s0 = 1.f) {
#pragma unroll
  for (int i = 0; i < 16; ++i) base[(size_t)(m0 + crow(i, lh)) * row_stride] = f2bf(a[i] * s0);
}

DI void stage_val(unsigned char* wl, int row, int col, float v) { *(bf16*)(wl + row * 144 + col * 2) = f2bf(v); }
DI void flush_unit(const unsigned char* wl, int nt, int lane, bf16* base, int stride) {
#pragma unroll
  for (int j = 0; j < 4; ++j) {
    const int c = lane + 64 * j, row = c >> 2, ch = c & 3;
    const u32x4 d = *(const u32x4*)(wl + row * 144 + nt * 64 + ch * 16);
    *(u32x4*)(base + (size_t)row * stride + ch * 8) = d;
  }
}

template <int MODE>
DI void gemm_tile(const Params& p, unsigned char* smem, int layer, int mtile, int ntile, int tid) {
  tid = launder(tid);
  const int li = layer >> 1;
  const int lane = tid & 63, lr = lane & 31, lh = lane >> 5;
  const int wave = __builtin_amdgcn_readfirstlane(tid >> 6);
  const int wm = wave >> 1, wn = wave & 1;
  const int m0 = mtile * 128, n0 = ntile * 128;
  const int m0w = m0 + wm * 64, n0w = n0 + wn * 64;
  const bool is_lat = m0 >= NCTX;
  unsigned char* ws = p.ws;
  const bf16* A; const bf16* B; int lda, K;
  bool tr = false;
  if (MODE == EP_EVEN_IN) { A = (const bf16*)(ws + OFF_HY); lda = 1024; K = 1024; B = (const bf16*)(ws + OFF_WEIN + li * SZ_WEIN); tr = (n0w >= 1024 && n0w < 1536); }
  else if (MODE == EP_ODD_IN) { A = (const bf16*)(ws + OFF_HY); lda = 1024; K = 1024; B = (const bf16*)(ws + OFF_WOIN + li * SZ_WOIN); tr = (n0w >= 1024 && n0w < 1536); }
  else if (MODE == EP_UPQ) { A = (const bf16*)(ws + OFF_QL); lda = 384; K = 384; B = (const bf16*)(ws + OFF_WUQ + li * SZ_WUQ); }
  else if (MODE == EP_UPKV) { A = (const bf16*)(ws + OFF_KVL); lda = 256; K = 256; B = (const bf16*)(ws + OFF_WUKV + li * SZ_WUKV); tr = ((n0w >> 6) & 1) != 0; }
  else { A = (const bf16*)(ws + OFF_HY); lda = 1024; K = 1024; B = (const bf16*)(ws + ((layer & 1) ? OFF_WOOUT : OFF_WEOUT) + li * SZ_WOUT); }
  A += (size_t)m0 * lda; B += (size_t)n0 * K;

  float* rs = (float*)(smem + 36864);
  if (MODE == EP_UPQ || MODE == EP_UPKV) {
    __syncthreads();
    const int row = tid >> 1, half = tid & 1, hk = K >> 1;
    const bf16* ar = A + (size_t)row * lda + half * hk;
    float ss = 0.f;
    for (int k = 0; k < hk; k += 8) {
      u32x4 u = *(const u32x4*)(ar + k);
      unsigned w4[4] = {u.x, u.y, u.z, u.w};
#pragma unroll
      for (int j = 0; j < 4; ++j) { float a = __uint_as_float(w4[j] << 16), b = __uint_as_float(w4[j] & 0xffff0000u); ss += a * a + b * b; }
    }
    ss += __shfl_xor(ss, 1);
    if (half == 0) rs[row] = rsqrtf(ss / (float)K + EPS);
  }

  f32x16 acc[2][2];
#pragma unroll
  for (int a = 0; a < 2; ++a)
#pragma unroll
    for (int b = 0; b < 2; ++b)
#pragma unroll
      for (int i = 0; i < 16; ++i) acc[a][b][i] = 0.f;
  if (tr) gemm_k<true>(A, lda, B, K, K, smem, acc, tid, lane, wm, wn);
  else gemm_k<false>(A, lda, B, K, K, smem, acc, tid, lane, wm, wn);
  if (MODE == EP_EVEN_IN || MODE == EP_ODD_IN) __syncthreads();
  unsigned char* wl = smem + wave * 9216;

  if (MODE == EP_OUT) {
    const float* gm = (const float*)(ws + OFF_MOD) + (layer * 2 + (is_lat ? 0 : 1)) * 3072 + 2048;
#pragma unroll
    for (int mt = 0; mt < 2; ++mt)
#pragma unroll
      for (int nt = 0; nt < 2; ++nt) {
        const int n = n0w + nt * 32 + lr; const float g = gm[n];
#pragma unroll
        for (int i = 0; i < 16; ++i) {
          const int m = m0w + mt * 32 + crow(i, lh);
          float* x = xrow(p, m) + n;
          const float xin = (layer == 0) ? xrow_in(p, m)[n] : *x;
          *x = xin + g * acc[mt][nt][i];
        }
      }
    return;
  }
  if (MODE == EP_UPQ) {
    const float2* t32 = (const float2*)(ws + OFF_T32);
#pragma unroll
    for (int mt = 0; mt < 2; ++mt)
#pragma unroll
      for (int nt = 0; nt < 2; ++nt) {
        const int nn = n0w + nt * 32, head = nn / 96, j0 = nn % 96;
        bf16* dst = (bf16*)(ws + OFF_QM) + (size_t)head * NT * 96 + j0 + lr;
        const bool rope = (j0 == 64) && is_lat;
#pragma unroll
        for (int i = 0; i < 16; ++i) {
          const int ml = wm * 64 + mt * 32 + crow(i, lh), m = m0 + ml;
          float v = acc[mt][nt][i] * rs[ml];
          if (rope) {
            float pv = __shfl_xor(v, 16);
            int t = m - NCTX, idx = lr & 15, pos = (idx < 8) ? (t >> 6) : (t & 63);
            float2 cs = t32[pos * 8 + (idx & 7)];
            v = (lr < 16) ? (v * cs.x - pv * cs.y) : (pv * cs.y + v * cs.x);
          }
          dst[(size_t)m * 96] = f2bf(v);
        }
      }
    return;
  }
  if (MODE == EP_UPKV) {
    const int head = n0w >> 7;
    if (!tr) {
#pragma unroll
      for (int mt = 0; mt < 2; ++mt)
#pragma unroll
        for (int nt = 0; nt < 2; ++nt) {
          bf16* dst = (bf16*)(ws + OFF_KM) + (size_t)head * NT * 96 + nt * 32 + lr;
#pragma unroll
          for (int i = 0; i < 16; ++i) { const int ml = wm * 64 + mt * 32 + crow(i, lh); dst[(size_t)(m0 + ml) * 96] = f2bf(acc[mt][nt][i] * rs[ml]); }
        }
    } else {
#pragma unroll
      for (int mt = 0; mt < 2; ++mt)
#pragma unroll
        for (int nt = 0; nt < 2; ++nt) {
          const int ml = wm * 64 + mt * 32 + lr; const float r = rs[ml];
          bf16* dst = (bf16*)(ws + OFF_VMT) + (size_t)head * 64 * NT + m0 + ml;
#pragma unroll
          for (int i = 0; i < 16; ++i) dst[(size_t)(nt * 32 + crow(i, lh)) * NT] = f2bf(acc[mt][nt][i] * r);
        }
    }
    return;
  }
  if (MODE == EP_EVEN_IN) {
    if (tr) {
#pragma unroll
      for (int mt = 0; mt < 2; ++mt)
#pragma unroll
        for (int nt = 0; nt < 2; ++nt) {
          const int nb = n0w - 1024 + nt * 32, m = m0w + mt * 32 + lr;
          bf16* dst = (bf16*)(ws + OFF_VAT) + (size_t)nb * NT + m;
#pragma unroll
          for (int i = 0; i < 16; ++i) dst[(size_t)crow(i, lh) * NT] = f2bf(acc[mt][nt][i]);
        }
      return;
    }
    const float2* t32 = (const float2*)(ws + OFF_T32);
#pragma unroll
    for (int mt = 0; mt < 2; ++mt)
#pragma unroll
      for (int nt = 0; nt < 2; ++nt) {
        const int nn = n0w + nt * 32;
        const bool krope = (nn >= 2688 && nn < 2720);
#pragma unroll
        for (int i = 0; i < 16; ++i) {
          const int ml = mt * 32 + crow(i, lh), m = m0w + ml;
          float v = acc[mt][nt][i];
          if (krope && is_lat) {
            float pv = __shfl_xor(v, 16);
            int t = m - NCTX, idx = lr & 15, pos = (idx < 8) ? (t >> 6) : (t & 63);
            float2 cs = t32[pos * 8 + (idx & 7)];
            v = (lr < 16) ? (v * cs.x - pv * cs.y) : (pv * cs.y + v * cs.x);
          }
          stage_val(wl, ml, nt * 32 + lr, v);
        }
      }
#pragma unroll
    for (int nt = 0; nt < 2; ++nt) {
      const int nn = n0w + nt * 32;
      bf16* base = nullptr; int stride = 0;
      if (nn < 512) { base = (bf16*)(ws + OFF_QA) + (size_t)(nn >> 6) * NT * 64 + (nn & 63); stride = 64; }
      else if (nn < 1024) { base = (bf16*)(ws + OFF_KA) + (size_t)((nn - 512) >> 6) * NT * 64 + (nn & 63); stride = 64; }
      else if (nn < 2048) { base = (bf16*)(ws + OFF_G) + (nn - 1536); stride = 1024; }
      else if (nn < 2432) { base = (bf16*)(ws + OFF_QL) + (nn - 2048); stride = 384; }
      else if (nn < 2688) { base = (bf16*)(ws + OFF_KVL) + (nn - 2432); stride = 256; }
      else if (nn < 2720) { base = (bf16*)(ws + OFF_KM) + 64; stride = 96; }
      else if (nn < E_IN) { base = (bf16*)(ws + OFF_G) + 512 + (nn - 2720); stride = 1024; }
      if (!base) continue;
      base += (size_t)m0w * stride;
      flush_unit(wl, nt, lane, base, stride);
      if (nn >= 2688 && nn < 2720) {
#pragma unroll 1
        for (int hh = 1; hh < 8; ++hh) flush_unit(wl, nt, lane, base + (size_t)hh * NT * 96, stride);
      }
    }
    return;
  }
  if (MODE == EP_ODD_IN) {
    if (tr) {
#pragma unroll
      for (int mt = 0; mt < 2; ++mt)
#pragma unroll
        for (int nt = 0; nt < 2; ++nt) {
          const int nb = n0w - 1024 + nt * 32, m = m0w + mt * 32 + lr;
          bf16* dst = (bf16*)(ws + OFF_VAT) + (size_t)nb * NT + m;
#pragma unroll
          for (int i = 0; i < 16; ++i) dst[(size_t)crow(i, lh) * NT] = f2bf(acc[mt][nt][i]);
        }
      return;
    }
    if (n0w < 1024) {
      const float2* t64 = (const float2*)(ws + OFF_T64);
      const int hw = (n0w & 511) >> 6;
      bf16* base = (bf16*)(ws + (n0w < 512 ? OFF_QA : OFF_KA)) + (size_t)hw * NT * 64;
#pragma unroll
      for (int mt = 0; mt < 2; ++mt) {
#pragma unroll
        for (int i = 0; i < 16; ++i) {
          const int m = m0w + mt * 32 + crow(i, lh);
          float x1 = acc[mt][0][i], x2 = acc[mt][1][i];
          if (is_lat) {
            int t = m - NCTX, pos = (lr < 16) ? (t >> 6) : (t & 63);
            float2 cs = t64[pos * 16 + (lr & 15)];
            float y1 = x1 * cs.x - x2 * cs.y, y2 = x1 * cs.y + x2 * cs.x;
            x1 = y1; x2 = y2;
          }
          stage_val(wl, mt * 32 + crow(i, lh), lr, x1);
          stage_val(wl, mt * 32 + crow(i, lh), 32 + lr, x2);
        }
      }
      flush_unit(wl, 0, lane, base + (size_t)m0w * 64, 64);
      flush_unit(wl, 1, lane, base + (size_t)m0w * 64 + 32, 64);
      return;
    }
#pragma unroll
    for (int mt = 0; mt < 2; ++mt)
#pragma unroll
      for (int nt = 0; nt < 2; ++nt) {
#pragma unroll
        for (int i = 0; i < 16; ++i) stage_val(wl, mt * 32 + crow(i, lh), nt * 32 + lr, acc[mt][nt][i]);
      }
#pragma unroll
    for (int nt = 0; nt < 2; ++nt) {
      const int nn = n0w + nt * 32;
      bf16* base; int stride;
      if (nn < 2048) { base = (bf16*)(ws + OFF_G) + (nn - 1536); stride = 1024; }
      else if (nn < 2560) { base = (bf16*)(ws + OFF_QL) + (nn - 2048); stride = 512; }
      else { base = (bf16*)(ws + OFF_G) + 512 + (nn - 2560); stride = 1024; }
      flush_unit(wl, nt, lane, base + (size_t)m0w * stride, stride);
    }
    return;
  }
}

DI float xmax32(float x) { auto r = __builtin_amdgcn_permlane32_swap(__float_as_uint(x), __float_as_uint(x), false, false); return fmaxf(__uint_as_float(r[0]), __uint_as_float(r[1])); }
DI float xsum32(float x) { auto r = __builtin_amdgcn_permlane32_swap(__float_as_uint(x), __float_as_uint(x), false, false); return __uint_as_float(r[0]) + __uint_as_float(r[1]); }
template <int DQK, int DV, int NS, int MODE, int NQ>
DI void attn_item(const Params& p, unsigned char* smem, int layer, int qb, int head, int tid) {
  tid = launder(tid);
  constexpr int KS = DQK * 2 + 16;
  constexpr int VS = 136;
  constexpr int KCH = DQK / 8;
  constexpr int NKC = 64 * KCH / 256;
  constexpr int NVC = DV * 8 / 256;
  constexpr int NDT = DV / 32;
  constexpr int NKS = DQK / 16;
  constexpr int K_BYTES = 64 * KS;
  unsigned char* ws = p.ws;
  const int li = layer >> 1;
  const int lane = tid & 63, lr = lane & 31, lh = lane >> 5;
  const int wave = __builtin_amdgcn_readfirstlane(tid >> 6);
  const bool qctx = qb < 2;

  const bf16* Qp[NS]; const bf16* Kp[NS]; const bf16* VT;
  float c;
  if (MODE == 0) { Qp[0] = (const bf16*)(ws + OFF_QM) + (size_t)head * NT * 96; Kp[0] = (const bf16*)(ws + OFF_KM) + (size_t)head * NT * 96;
                   VT = (const bf16*)(ws + OFF_VMT) + (size_t)head * 64 * NT; c = 0.10206207261596577f * LOG2E; }
  else if (MODE == 1) { Qp[0] = (const bf16*)(ws + OFF_QA) + (size_t)head * NT * 64; Kp[0] = (const bf16*)(ws + OFF_KA) + (size_t)head * NT * 64;
                   VT = (const bf16*)(ws + OFF_VAT) + (size_t)head * 64 * NT; c = 0.125f * LOG2E; }
  else {
#pragma unroll
    for (int s = 0; s < NS; ++s) { Qp[s] = (const bf16*)(ws + OFF_QA) + (size_t)(head * 2 + s) * NT * 64; Kp[s] = (const bf16*)(ws + OFF_KA) + (size_t)(head * 2 + s) * NT * 64; }
    VT = (const bf16*)(ws + OFF_VAT) + (size_t)head * 128 * NT; c = 0.125f * LOG2E;
  }

  int ntiles, kr_lo = 0, r_w = 0, r0w = 0, qc = 0, c0 = 0;
  if (qctx) ntiles = 4;
  else if (MODE == 1) {
    const int lb = qb - 2, ra_ = 2 * lb, rb_ = 2 * lb + 1;
    int r0a = min(max(ra_ - 4, 0), 248), r0b = min(max(rb_ - 4, 0), 248);
    kr_lo = r0a; ntiles = 4 + (r0b + 8 - r0a);
    r_w = 2 * lb + (wave >> 1); r0w = min(max(r_w - 4, 0), 248);
    qc = (wave & 1) * 32 + lr; c0 = min(max(qc - 8, 0), 48);
  } else ntiles = NT / 64;

  float* rpb = (float*)(smem + NS * K_BYTES + DV * VS);
  if (MODE == 1) {
    __syncthreads();
    const float* src = p.in[I_RPB] + (size_t)(li * 8 + head) * 465;
    for (int i = tid; i < 465; i += 256) rpb[i] = src[i] * LOG2E;
  }

  int tq[NQ];
#pragma unroll
  for (int n = 0; n < NQ; ++n) tq[n] = (qb + n) * 128 + wave * 32 + lr;
  bf16x8 qf[NQ][NS][NKS];
#pragma unroll
  for (int n = 0; n < NQ; ++n)
#pragma unroll
    for (int s = 0; s < NS; ++s)
#pragma unroll
      for (int ks = 0; ks < NKS; ++ks) qf[n][s][ks] = *(const bf16x8*)(Qp[s] + (size_t)tq[n] * DQK + ks * 16 + lh * 8);

  f32x16 O[NQ][NS][NDT];
#pragma unroll
  for (int n = 0; n < NQ; ++n)
#pragma unroll
    for (int s = 0; s < NS; ++s)
#pragma unroll
      for (int d = 0; d < NDT; ++d)
#pragma unroll
        for (int i = 0; i < 16; ++i) O[n][s][d][i] = 0.f;
  float mrun[NQ][NS], lrun[NQ][NS];
#pragma unroll
  for (int n = 0; n < NQ; ++n)
#pragma unroll
    for (int s = 0; s < NS; ++s) { mrun[n][s] = -1e30f; lrun[n][s] = 0.f; }

  constexpr bool PF = (MODE != 2);
  u32x4 rk[NS][NKC], rv[NVC];
  auto tile_tok = [&](int it) -> int { return (MODE == 1 && !qctx && it >= 4) ? (NCTX + (kr_lo + it - 4) * 64) : it * 64; };
  auto gload = [&](int it) {
    const int t0 = tile_tok(it);
#pragma unroll
    for (int s = 0; s < NS; ++s)
#pragma unroll
      for (int i = 0; i < NKC; ++i) { int cidx = tid + 256 * i, row = cidx / KCH, cj = cidx % KCH; rk[s][i] = *(const u32x4*)(Kp[s] + (size_t)(t0 + row) * DQK + cj * 8); }
#pragma unroll
    for (int i = 0; i < NVC; ++i) { int cidx = tid + 256 * i, row = cidx >> 3, cj = cidx & 7; rv[i] = *(const u32x4*)(VT + (size_t)row * NT + t0 + cj * 8); }
  };
  if (PF) gload(0);

#pragma unroll 1
  for (int it = 0; it < ntiles; ++it) {
    __syncthreads();
    if (!PF) gload(it);
#pragma unroll
    for (int s = 0; s < NS; ++s)
#pragma unroll
      for (int i = 0; i < NKC; ++i) { int cidx = tid + 256 * i, row = cidx / KCH, cj = cidx % KCH; *(u32x4*)(smem + s * K_BYTES + row * KS + cj * 16) = rk[s][i]; }
#pragma unroll
    for (int i = 0; i < NVC; ++i) { int cidx = tid + 256 * i, row = cidx >> 3, cj = cidx & 7;
      u32x2* d = (u32x2*)(smem + NS * K_BYTES + row * VS + cj * 16); u32x2 d0 = {rv[i].x, rv[i].y}, d1 = {rv[i].z, rv[i].w}; d[0] = d0; d[1] = d1; }
    __syncthreads();
    if (PF && it + 1 < ntiles) gload(it + 1);

    bool active = true; int kr = 0;
    if (MODE == 1 && !qctx && it >= 4) { kr = kr_lo + it - 4; active = (kr >= r0w) && (kr < r0w + 8); }
    if (!active) continue;

#pragma unroll(MODE == 2 ? 1 : 2)
    for (int sub = 0; sub < 2; ++sub) {
      bf16x8 P[NQ][NS][2];
#pragma unroll
      for (int s = 0; s < NS; ++s) {
        f32x16 S[NQ];
#pragma unroll
        for (int n = 0; n < NQ; ++n)
#pragma unroll
          for (int i = 0; i < 16; ++i) S[n][i] = 0.f;
#pragma unroll
        for (int ks = 0; ks < NKS; ++ks) {
          bf16x8 kf = *(const bf16x8*)(smem + s * K_BYTES + (sub * 32 + lr) * KS + ks * 32 + lh * 16);
#pragma unroll
          for (int n = 0; n < NQ; ++n) S[n] = MFMA(kf, qf[n][s][ks], S[n]);
        }
#pragma unroll
        for (int n = 0; n < NQ; ++n) {
          float cc = c;
          if (MODE == 1) {
            cc = 1.f;
            if (!qctx && it >= 4) {
              const float* brow = rpb + (kr - r_w + 7) * 31;
#pragma unroll
              for (int i = 0; i < 16; ++i) {
                const int kc = sub * 32 + crow(i, lh);
                const bool valid = (kc >= c0) && (kc < c0 + 16);
                const int bi = min(max(kc - qc + 15, 0), 30);
                S[n][i] = valid ? (S[n][i] * c + brow[bi]) : -1e30f;
              }
            } else {
#pragma unroll
              for (int i = 0; i < 16; ++i) S[n][i] = S[n][i] * c;
            }
          }
          float mx = S[n][0];
#pragma unroll
          for (int i = 1; i < 16; ++i) mx = fmaxf(mx, S[n][i]);
          mx = xmax32(mx);
          const float mnew = fmaxf(mrun[n][s], mx);
          if (__any(mnew > mrun[n][s])) {
            const float alpha = __builtin_amdgcn_exp2f((mrun[n][s] - mnew) * cc);
            lrun[n][s] *= alpha;
#pragma unroll
            for (int d = 0; d < NDT; ++d)
#pragma unroll
              for (int i = 0; i < 16; ++i) O[n][s][d][i] *= alpha;
            mrun[n][s] = mnew;
          }
          const float mc = mrun[n][s] * cc;
          float ls0 = 0.f, ls1 = 0.f;
#pragma unroll
          for (int i = 0; i < 16; i += 2) { S[n][i] = __builtin_amdgcn_exp2f(S[n][i] * cc - mc); S[n][i + 1] = __builtin_amdgcn_exp2f(S[n][i + 1] * cc - mc); ls0 += S[n][i]; ls1 += S[n][i + 1]; }
          lrun[n][s] += ls0 + ls1;
#pragma unroll
          for (int s2 = 0; s2 < 2; ++s2) {
            u32x4 u = {pack2(S[n][8 * s2 + 0], S[n][8 * s2 + 1]), pack2(S[n][8 * s2 + 2], S[n][8 * s2 + 3]),
                       pack2(S[n][8 * s2 + 4], S[n][8 * s2 + 5]), pack2(S[n][8 * s2 + 6], S[n][8 * s2 + 7])};
            P[n][s][s2] = __builtin_bit_cast(bf16x8, u);
          }
        }
      }
#pragma unroll
      for (int d = 0; d < NDT; ++d)
#pragma unroll
        for (int s2 = 0; s2 < 2; ++s2) {
          const unsigned char* vp = smem + NS * K_BYTES + (d * 32 + lr) * VS + (sub * 32 + 16 * s2 + 4 * lh) * 2;
          u32x2 lo = *(const u32x2*)vp, hi = *(const u32x2*)(vp + 16);
          u32x4 u = {lo.x, lo.y, hi.x, hi.y};
          bf16x8 vf = __builtin_bit_cast(bf16x8, u);
#pragma unroll
          for (int n = 0; n < NQ; ++n)
#pragma unroll
            for (int s = 0; s < NS; ++s) O[n][s][d] = MFMA(vf, P[n][s][s2], O[n][s][d]);
        }
    }
  }

#pragma unroll
  for (int n = 0; n < NQ; ++n) {
    float inv[NS];
#pragma unroll
    for (int s = 0; s < NS; ++s) inv[s] = 1.f / xsum32(lrun[n][s]);
    bf16* yrow = (bf16*)(ws + OFF_HY) + (size_t)tq[n] * 1024;
    const bf16* grow = (const bf16*)(ws + OFF_G) + (size_t)tq[n] * 1024;
    if (MODE != 2) {
      const int col0 = (MODE == 0 ? 512 : 0) + head * 64;
#pragma unroll
      for (int d = 0; d < NDT; ++d)
#pragma unroll
        for (int g4 = 0; g4 < 4; ++g4) {
          const int col = col0 + d * 32 + 8 * g4 + 4 * lh;
          u32x2 gu = *(const u32x2*)(grow + col);
          float g0 = __uint_as_float(gu.x << 16), g1 = __uint_as_float(gu.x & 0xffff0000u), g2 = __uint_as_float(gu.y << 16), g3 = __uint_as_float(gu.y & 0xffff0000u);
          float y0 = O[n][0][d][4 * g4 + 0] * inv[0] * silu(g0), y1 = O[n][0][d][4 * g4 + 1] * inv[0] * silu(g1);
          float y2 = O[n][0][d][4 * g4 + 2] * inv[0] * silu(g2), y3 = O[n][0][d][4 * g4 + 3] * inv[0] * silu(g3);
          { u32x2 yo = {pack2(y0, y1), pack2(y2, y3)}; *(u32x2*)(yrow + col) = yo; }
        }
    } else {
      const float lam_init = __uint_as_float((unsigned)__builtin_amdgcn_readfirstlane((layer == 1) ? 0x3eb60549 : 0x3f0e59d5));
      float v1 = p.in[I_LQ1][li * 64 + lane] * p.in[I_LK1][li * 64 + lane];
      float v2 = p.in[I_LQ2][li * 64 + lane] * p.in[I_LK2][li * 64 + lane];
      v1 = wave_sum(v1); v2 = wave_sum(v2);
      const float lam = __expf(v1) - __expf(v2) + lam_init;
      float ss = 0.f;
#pragma unroll
      for (int d = 0; d < NDT; ++d)
#pragma unroll
        for (int i = 0; i < 16; ++i) { float o = O[n][0][d][i] * inv[0] - lam * (O[n][NS - 1][d][i] * inv[NS - 1]); O[n][0][d][i] = o; ss += o * o; }
      ss = xsum32(ss);
      const float rstd = rsqrtf(ss * (1.f / 128.f) + EPS) * (1.f - lam_init);
      const float* sub = p.in[I_SUBLN] + li * 128;
      const int col0 = head * 128;
#pragma unroll
      for (int d = 0; d < NDT; ++d)
#pragma unroll
        for (int g4 = 0; g4 < 4; ++g4) {
          const int dd = d * 32 + 8 * g4 + 4 * lh, col = col0 + dd;
          u32x2 gu = *(const u32x2*)(grow + col);
          float g0 = __uint_as_float(gu.x << 16), g1 = __uint_as_float(gu.x & 0xffff0000u), g2 = __uint_as_float(gu.y << 16), g3 = __uint_as_float(gu.y & 0xffff0000u);
          float4 sl = *(const float4*)(sub + dd);
          float y0 = O[n][0][d][4 * g4 + 0] * rstd * sl.x * silu(g0), y1 = O[n][0][d][4 * g4 + 1] * rstd * sl.y * silu(g1);
          float y2 = O[n][0][d][4 * g4 + 2] * rstd * sl.z * silu(g2), y3 = O[n][0][d][4 * g4 + 3] * rstd * sl.w * silu(g3);
          { u32x2 yo = {pack2(y0, y1), pack2(y2, y3)}; *(u32x2*)(yrow + col) = yo; }
        }
    }
  }
}

template <bool PASS2>
DI void lru_item(const Params& p, unsigned char* smem, int layer, int chunk, int g, int tid) {
  tid = launder(tid);
  const int oi = layer >> 1;
  unsigned char* ws = p.ws;
  float* us = (float*)smem;
  unsigned char* ubf = smem + 16384;
  float2* ab = (float2*)(smem + 25600);
  float2* seg = (float2*)(smem + 58368);
  float2* seg2 = seg + 256;
  const int j = tid & 63, tg = tid >> 6, ch = g * 64 + j;
  const int t0 = chunk * 64;
  const int seq_lo = chunk < 4 ? 0 : NCTX, seq_hi = chunk < 4 ? NCTX : NT;
  const bf16* lx = (const bf16*)(ws + OFF_QL);
  __syncthreads();
  if (PASS2) {
    const float2* carp = (const float2*)(ws + OFF_CAR);
#pragma unroll
    for (int d = 0; d < 2; ++d) {
      const int npre = (d == 0) ? chunk : (chunk < 4 ? 3 - chunk : 4 + (NCHUNK - 1 - chunk));
      const int i0 = (npre * tg) >> 2, i1 = (npre * (tg + 1)) >> 2;
      float2 cv[65];
#pragma unroll
      for (int q = 0; q < 65; ++q) {
        const int idx = i0 + q;
        const int cc = (d == 0) ? idx : (idx < 4 ? 3 - idx : NCHUNK + 3 - idx);
        cv[q] = make_float2(1.f, 0.f);
        if (idx < i1) cv[q] = carp[(size_t)(cc * 2 + d) * 512 + ch];
      }
      float A = 1.f, B = 0.f;
#pragma unroll
      for (int q = 0; q < 65; ++q) { B = cv[q].x * B + cv[q].y; A *= cv[q].x; }
      seg2[(d * 4 + tg) * 64 + j] = make_float2(A, B);
    }
  }
  {
    const float* cw = p.in[I_CONVW] + (size_t)oi * 4 * 512;
    const float w0 = cw[ch], w1 = cw[512 + ch], w2 = cw[1024 + ch], w3 = cw[1536 + ch], cb = p.in[I_CONVB][oi * 512 + ch];
    float xv[19];
#pragma unroll
    for (int i = 0; i < 19; ++i) { int t = t0 + tg * 16 - 2 + i; xv[i] = (t >= seq_lo && t < seq_hi) ? bf2f(lx[(size_t)t * 512 + ch]) : 0.f; }
#pragma unroll
    for (int tt = 0; tt < 16; ++tt) {
      const float uv = cb + xv[tt] * w0 + xv[tt + 1] * w1 + xv[tt + 2] * w2 + xv[tt + 3] * w3;
      us[(tg * 16 + tt) * 64 + j] = uv;
      *(bf16*)(ubf + (tg * 16 + tt) * 144 + j * 2) = f2bf(uv);
    }
  }
  float hs[16];
#pragma unroll
  for (int i = 0; i < 16; ++i) hs[i] = 0.f;
  float2* car = (float2*)(ws + OFF_CAR);

#pragma unroll 1
  for (int d = 0; d < 2; ++d) {
    __syncthreads();
    {
      const int wave = __builtin_amdgcn_readfirstlane(tid >> 6);
      const int lane = tid & 63, lr = lane & 31, lh = lane >> 5;
      const int mt = wave >> 1, nt = wave & 1;
      const bf16* wt = (const bf16*)(ws + OFF_LW) + (size_t)(((oi * 2 + d) * 8 + g) * 2) * 4096 + (nt * 32 + lr) * 64 + lh * 8;
      f32x16 ca, cx;
#pragma unroll
      for (int i = 0; i < 16; ++i) { ca[i] = 0.f; cx[i] = 0.f; }
#pragma unroll
      for (int ks = 0; ks < 4; ++ks) {
        const bf16x8 af = *(const bf16x8*)(ubf + (mt * 32 + lr) * 144 + ks * 32 + lh * 16);
        const bf16x8 ba_ = *(const bf16x8*)(wt + ks * 16);
        const bf16x8 bx_ = *(const bf16x8*)(wt + 4096 + ks * 16);
        ca = MFMA(af, ba_, ca);
        cx = MFMA(af, bx_, cx);
      }
      const int cj = nt * 32 + lr, chj = g * 64 + cj;
      const float ba = p.in[I_BA][(oi * 2 + d) * 512 + chj], bx = p.in[I_BX][(oi * 2 + d) * 512 + chj];
      const float sp = log1pf(__expf(-p.in[I_LAMBDA][(oi * 2 + d) * 512 + chj]));
#pragma unroll
      for (int i = 0; i < 16; ++i) {
        const int t = mt * 32 + crow(i, lh);
        const float r = sigm(ca[i] + ba), ig = sigm(cx[i] + bx);
        const float a = __expf(-8.f * r * sp);
        const float b = __builtin_amdgcn_sqrtf(fmaxf(1.f - a * a, 0.f)) * (ig * us[t * 64 + cj]);
        ab[t * 64 + cj] = make_float2(a, b);
      }
    }
    __syncthreads();
    float ar[16], ai[16];
    float Ap = 1.f, Bp = 0.f;
#pragma unroll
    for (int q = 0; q < 16; ++q) {
      const int tt = d ? 15 - q : q;
      const float2 v = ab[(tg * 16 + tt) * 64 + j];
      ar[tt] = v.x; ai[tt] = v.y;
      Bp = v.x * Bp + v.y; Ap *= v.x;
    }
    seg[tg * 64 + j] = make_float2(Ap, Bp);
    __syncthreads();
    if (!PASS2) {
      if (tg == 0) {
        float A = 1.f, B = 0.f;
#pragma unroll
        for (int q = 0; q < 4; ++q) { float2 sg = seg[(d ? 3 - q : q) * 64 + j]; B = sg.x * B + sg.y; A *= sg.x; }
        car[(size_t)(chunk * 2 + d) * 512 + ch] = make_float2(A, B);
      }
    } else {
      float h = 0.f;
#pragma unroll
      for (int q = 0; q < 4; ++q) { float2 sg = seg2[(d * 4 + q) * 64 + j]; h = sg.x * h + sg.y; }
      if (d == 0) {
        for (int q = 0; q < tg; ++q) { float2 sg = seg[q * 64 + j]; h = sg.x * h + sg.y; }
#pragma unroll
        for (int tt = 0; tt < 16; ++tt) { h = ar[tt] * h + ai[tt]; hs[tt] += h; }
      } else {
        for (int q = 3; q > tg; --q) { float2 sg = seg[q * 64 + j]; h = sg.x * h + sg.y; }
#pragma unroll
        for (int tt = 15; tt >= 0; --tt) { h = ar[tt] * h + ai[tt]; hs[tt] += h; }
      }
    }
  }
  if (PASS2) {
    const bf16* G = (const bf16*)(ws + OFF_G);
    bf16* Y = (bf16*)(ws + OFF_HY);
#pragma unroll
    for (int tt = 0; tt < 16; ++tt) {
      const size_t o = (size_t)(t0 + tg * 16 + tt) * 1024 + 512 + ch;
      Y[o] = f2bf(hs[tt] * silu(bf2f(G[o])));
    }
  }
}


DI void grid_barrier(unsigned* bar, unsigned k, unsigned nb) {
  asm volatile("s_waitcnt vmcnt(0) lgkmcnt(0)" ::: "memory");
  __syncthreads();
  if (threadIdx.x == 0) {
    __builtin_amdgcn_fence(__ATOMIC_RELEASE, "agent");
    asm volatile("s_waitcnt vmcnt(0)" ::: "memory");
    const unsigned g = blockIdx.x & 7u;
    const unsigned ngroups = nb < 8u ? nb : 8u;
    const unsigned gsize = (nb - g + 7u) >> 3;
    const unsigned old = __hip_atomic_fetch_add(bar + 128 + 32 * g, 1u, __ATOMIC_RELAXED, __HIP_MEMORY_SCOPE_AGENT);
    if (old == gsize * k - 1u) {
      const unsigned old2 = __hip_atomic_fetch_add(bar, 1u, __ATOMIC_RELAXED, __HIP_MEMORY_SCOPE_AGENT);
      if (old2 == ngroups * k - 1u) __hip_atomic_store(bar + 64, k, __ATOMIC_RELAXED, __HIP_MEMORY_SCOPE_AGENT);
    }
    while (__hip_atomic_load(bar + 64, __ATOMIC_RELAXED, __HIP_MEMORY_SCOPE_AGENT) < k) __builtin_amdgcn_s_sleep(4);
    __builtin_amdgcn_fence(__ATOMIC_ACQUIRE, "agent");
    asm volatile("s_waitcnt vmcnt(0)" ::: "memory");
  }
  __syncthreads();
}

DI int grab_item(unsigned* ctr, int base, int wv, int* slot) {
  const int t = launder(wv);
  __syncthreads();
  if (t == 0) *slot = base + (int)__hip_atomic_fetch_add(ctr, 1u, __ATOMIC_RELAXED, __HIP_MEMORY_SCOPE_AGENT);
  __syncthreads();
  return __builtin_amdgcn_readfirstlane(*slot);
}

constexpr int N_PHASES = 22;

__global__ void __launch_bounds__(256, 2) mega(Params p, int ph_lo, int ph_hi) {
  __shared__ __attribute__((aligned(16))) unsigned char smem[LDS_BYTES];
  __shared__ int s_item;
  const int tid = __builtin_amdgcn_readfirstlane(threadIdx.x >> 6);
  const int nb = gridDim.x;
  if ((int)blockIdx.x < (nb >> 1)) __builtin_amdgcn_s_setprio(1);
#pragma unroll 1
  for (int ph = ph_lo; ph < ph_hi; ++ph) {
    if (ph > ph_lo) {
      if (ph_hi < 0) cg::this_grid().sync();
      grid_barrier((unsigned*)(p.ws + OFF_BAR), (unsigned)(ph - ph_lo), (unsigned)nb);
    }
    if (ph == 0) {
      constexpr int n_items = 192 + 64 + 24 + N_WEARLY;
      unsigned* ctr0 = (unsigned*)(p.ws + OFF_BAR) + 32;
      for (int it = blockIdx.x; it < n_items; it = grab_item(ctr0, nb, tid, &s_item)) {
        if (it < 192) prep_mod(p, smem, it, tid);
        else if (it < 256) prep_lruw(p, smem, it - 192, tid);
        else if (it < 280) prep_tab(p, it - 256, tid);
        else prep_wtile(p, smem, it - 280, tid);
      }
      continue;
    }
    if (ph == N_PHASES - 1) {
      for (int it = blockIdx.x; it < 4096; it += nb) final_rows(p, it, tid);
      continue;
    }
    const int layer = (ph - 1) / 5, sub = (ph - 1) % 5;
    const bool odd = layer & 1;
    unsigned* ctr = (unsigned*)(p.ws + OFF_BAR) + 32 + ph;
#define NEXT_ITEM grab_item(ctr, nb, tid, &s_item)
    if (sub == 0) {
      for (int it = blockIdx.x; it < NT / 4; it += nb) norm_rows(p, layer, it, tid);
    } else if (sub == 1) {
      if (!odd) { for (int it = blockIdx.x; it < 130 * 26; it = NEXT_ITEM) gemm_tile<EP_EVEN_IN>(p, smem, layer, it / 26, it % 26, tid); }
      else { for (int it = blockIdx.x; it < 130 * 24; it = NEXT_ITEM) gemm_tile<EP_ODD_IN>(p, smem, layer, it / 24, it % 24, tid); }
    } else if (sub == 2) {
      if (!odd) {
        for (int it = blockIdx.x; it < 130 * 14; it = NEXT_ITEM) {
          const int mt = it / 14, nt = it % 14;
          if (nt < 6) gemm_tile<EP_UPQ>(p, smem, layer, mt, nt, tid);
          else gemm_tile<EP_UPKV>(p, smem, layer, mt, nt - 6, tid);
        }
      } else {
        for (int it = blockIdx.x; it < NCHUNK * 8; it = NEXT_ITEM) lru_item<false>(p, smem, layer, it >> 3, it & 7, tid);
      }
    } else if (sub == 3) {
      if (!odd) {
        const int n_fill = (layer == 0) ? (N_WTILES - N_WEARLY) : 0;
        for (int it = blockIdx.x; it < 520 + 1040 + n_fill; it = NEXT_ITEM) {
          if (it >= 1560) { prep_wtile(p, smem, N_WEARLY + it - 1560, tid); continue; }
          if (it < 520) {
            const int head = it & 7, pi = it >> 3;
            const int qb = pi < 64 ? 2 + 2 * pi : 0;
            attn_item<96, 64, 1, 0, 2>(p, smem, layer, qb, head, tid);
          } else {
            const int idx = it - 520;
            const int head = idx & 7, qbi = idx >> 3;
            const int qb = qbi < 128 ? qbi + 2 : qbi - 128;
            attn_item<64, 64, 1, 1, 1>(p, smem, layer, qb, head, tid);
          }
        }
      } else {
        for (int it = blockIdx.x; it < 520 + NCHUNK * 8; it = NEXT_ITEM) {
          if (it < 520) {
            const int head = it & 3, qbi = it >> 2;
            const int qb = qbi < 128 ? qbi + 2 : qbi - 128;
#ifndef NO_DIFF
            attn_item<64, 128, 2, 2, 1>(p, smem, layer, qb, head, tid);
#endif
          } else {
            const int k = it - 520;
#ifndef NO_LRU
            lru_item<true>(p, smem, layer, k >> 3, k & 7, tid);
#endif
          }
        }
      }
    } else {
      const int skip = (layer == 3) ? 16 : 0;
      for (int it = blockIdx.x; it < 130 * 8 - skip; it = NEXT_ITEM) gemm_tile<EP_OUT>(p, smem, layer, (it + skip) >> 3, (it + skip) & 7, tid);
    }
  }
}

extern "C" void kernel_launch(void* const* d_in, const int* in_sizes, int n_in, void* d_out, int out_size, void* d_ws, size_t ws_size,
                              hipStream_t stream) {
  static int grid_blocks = 0;
  if (!grid_blocks) {
    int dev = 0, cus = 0, per_cu = 0;
    hipGetDevice(&dev);
    hipDeviceGetAttribute(&cus, hipDeviceAttributeMultiprocessorCount, dev);
    hipOccupancyMaxActiveBlocksPerMultiprocessor(&per_cu, mega, 256, 0);
    if (per_cu < 1) per_cu = 1;
    if (per_cu > 2) per_cu = 2;
    grid_blocks = cus * per_cu;
    if (ws_size < WS_END) fprintf(stderr, "kernel_launch: workspace too small (%zu < %zu)\n", ws_size, (size_t)WS_END);
  }
  Params p{};
  for (int i = 0; i < 29; ++i) p.in[i] = (const float*)d_in[i];
  p.out = (float*)d_out; p.ws = (unsigned char*)d_ws;
#if COOP
  hipMemsetAsync((unsigned char*)d_ws + OFF_BAR, 0, 2048, stream);
  int lo = 0, hi = N_PHASES;
  void* args[] = {&p, &lo, &hi};
  hipError_t e = hipLaunchCooperativeKernel((void*)mega, dim3(grid_blocks), dim3(256), args, 0, stream);
  if (e != hipSuccess) fprintf(stderr, "cooperative launch failed: %s (grid %d)\n", hipGetErrorString(e), grid_blocks);
#else
  for (int ph = 0; ph < N_PHASES; ++ph) hipLaunchKernelGGL(mega, dim3(grid_blocks), dim3(256), 0, stream, p, ph, ph + 1);
#endif
}
```

```cpp
#include <hip/hip_runtime.h>
#include <hip/hip_cooperative_groups.h>
#include <cstdio>
namespace cg = cooperative_groups;

#ifndef COOP
#define COOP 1
#endif

#define DI __device__ __forceinline__
typedef unsigned short bf16;
using bf16x8 = __attribute__((ext_vector_type(8))) short;
using f32x16 = __attribute__((ext_vector_type(16))) float;
typedef __bf16 v2bf __attribute__((ext_vector_type(2)));
typedef float v2f __attribute__((ext_vector_type(2)));
typedef unsigned u32x4 __attribute__((ext_vector_type(4)));
typedef unsigned u32x2 __attribute__((ext_vector_type(2)));
#define MFMA(a, b, c) __builtin_amdgcn_mfma_f32_32x32x16_bf16((a), (b), (c), 0, 0, 0)

constexpr int NT = 16640;
constexpr int NCTX = 256;
constexpr int E_IN = 3232, E_INP = 3328, O_IN = 3072;
constexpr float EPS = 1e-6f;
constexpr float LOG2E = 1.4426950408889634f;
constexpr int NCHUNK = 260;

constexpr size_t al(size_t x) { return (x + 255) & ~size_t(255); }
constexpr size_t OFF_XC   = 0;
constexpr size_t OFF_MOD  = OFF_XC + al(256 * 1024 * 4);
constexpr size_t OFF_T64  = OFF_MOD + al(4 * 2 * 3072 * 4);
constexpr size_t OFF_T32  = OFF_T64 + al(256 * 16 * 8);
constexpr size_t OFF_CAR  = OFF_T32 + al(256 * 8 * 8);
constexpr size_t SZ_WEIN  = (size_t)E_INP * 1024 * 2;
constexpr size_t SZ_WOUT  = (size_t)1024 * 1024 * 2;
constexpr size_t SZ_WUQ   = (size_t)768 * 384 * 2;
constexpr size_t SZ_WUKV  = (size_t)1024 * 256 * 2;
constexpr size_t SZ_WOIN  = (size_t)O_IN * 1024 * 2;
constexpr size_t OFF_WEIN = OFF_CAR + al(NCHUNK * 2 * 512 * 8);
constexpr size_t OFF_WEOUT = OFF_WEIN + 2 * SZ_WEIN;
constexpr size_t OFF_WUQ  = OFF_WEOUT + 2 * SZ_WOUT;
constexpr size_t OFF_WUKV = OFF_WUQ + 2 * SZ_WUQ;
constexpr size_t OFF_WOIN = OFF_WUKV + 2 * SZ_WUKV;
constexpr size_t OFF_WOOUT = OFF_WOIN + 2 * SZ_WOIN;
constexpr size_t OFF_HY   = OFF_WOOUT + 2 * SZ_WOUT;
constexpr size_t OFF_G    = OFF_HY + (size_t)NT * 1024 * 2;
constexpr size_t SZ_H64   = (size_t)8 * NT * 64 * 2;
constexpr size_t OFF_QA   = OFF_G + (size_t)NT * 1024 * 2;
constexpr size_t OFF_KA   = OFF_QA + SZ_H64;
constexpr size_t OFF_VAT  = OFF_KA + SZ_H64;
constexpr size_t OFF_QL   = OFF_VAT + SZ_H64;
constexpr size_t OFF_KVL  = OFF_QL + (size_t)NT * 384 * 2;
constexpr size_t OFF_QM   = OFF_KVL + (size_t)NT * 256 * 2;
constexpr size_t OFF_KM   = OFF_QM + (size_t)8 * NT * 96 * 2;
constexpr size_t OFF_VMT  = OFF_KM + (size_t)8 * NT * 96 * 2;
constexpr size_t OFF_BAR  = OFF_VMT + SZ_H64;
constexpr size_t OFF_LW   = OFF_BAR + 2048;
constexpr size_t WS_END   = OFF_LW + (size_t)64 * 4096 * 2;
static_assert(WS_END <= (size_t)256 * 1024 * 1024, "workspace too large");

constexpr int LDS_BYTES = 63 * 1024;

struct Params { const float* in[29]; float* out; unsigned char* ws; };

enum { I_X = 0, I_C, I_CTX, I_CCTX, I_MODW, I_MODB, I_NORMG, I_FINALG, I_EWIN, I_EWOUT, I_RPB, I_QNORM, I_WUQ, I_KVNORM, I_WUKV,
       I_OWIN, I_OWOUT, I_LQ1, I_LK1, I_LQ2, I_LK2, I_SUBLN, I_CONVW, I_CONVB, I_LAMBDA, I_WA, I_BA, I_WX, I_BX };

DI float bf2f(bf16 u) { return __uint_as_float(((unsigned)u) << 16); }
DI unsigned pack2(float a, float b) { v2f x = {a, b}; v2bf r = __builtin_convertvector(x, v2bf); return __builtin_bit_cast(unsigned, r); }
DI bf16 f2bf(float x) { return (bf16)pack2(x, x); }
DI int crow(int i, int h) { return (i & 3) + 8 * (i >> 2) + 4 * h; }
DI float sigm(float x) { return __builtin_amdgcn_rcpf(1.f + __expf(-x)); }
DI float silu(float x) { return x * sigm(x); }
DI float wave_sum(float v) {
#pragma unroll
  for (int o = 32; o > 0; o >>= 1) v += __shfl_xor(v, o);
  return v;
}
DI int launder(int wv) { int l; asm volatile("v_mbcnt_lo_u32_b32 %0, -1, 0\n\tv_mbcnt_hi_u32_b32 %0, -1, %0" : "=v"(l)); return (wv << 6) + l; }
DI float* xrow(const Params& p, int row) {
  return row < NCTX ? (float*)(p.ws + OFF_XC) + (size_t)row * 1024 : p.out + (size_t)(row - NCTX) * 1024;
}

DI const float* xrow_in(const Params& p, int row) {
  return row < NCTX ? p.in[I_CTX] + (size_t)row * 1024 : p.in[I_X] + (size_t)(row - NCTX) * 1024;
}

DI void prep_wtile(const Params& p, unsigned char* smem, int item, int tid) {
  tid = launder(tid);
  int lay = 0, kind = 0, K = 0, N = 0, NP = 0; const float* src = nullptr; const float* gv = nullptr; bf16* dst = nullptr;
  int rem = item;
  const unsigned long long order = 0xBA9875312640ull;
#pragma unroll 1
  for (int q = 0; q < 12; ++q) {
    const int d = (int)((order >> (4 * q)) & 15ull);
    kind = d >> 1; lay = d & 1;
    switch (kind) {
      case 0: K = 1024; N = E_IN; NP = E_INP; break;
      case 1: K = 1024; N = 1024; NP = 1024; break;
      case 2: K = 384; N = 768; NP = 768; break;
      case 3: K = 256; N = 1024; NP = 1024; break;
      case 4: K = 1024; N = O_IN; NP = O_IN; break;
      default: K = 1024; N = 1024; NP = 1024; break;
    }
    int nt = (K >> 6) * (NP >> 6);
    if (rem < nt) break;
    rem -= nt;
  }
  switch (kind) {
    case 0: src = p.in[I_EWIN] + (size_t)lay * 1024 * E_IN; dst = (bf16*)(p.ws + OFF_WEIN + lay * SZ_WEIN); break;
    case 1: src = p.in[I_EWOUT] + (size_t)lay * 1024 * 1024; dst = (bf16*)(p.ws + OFF_WEOUT + lay * SZ_WOUT); break;
    case 2: src = p.in[I_WUQ] + (size_t)lay * 384 * 768; dst = (bf16*)(p.ws + OFF_WUQ + lay * SZ_WUQ); gv = p.in[I_QNORM] + lay * 384; break;
    case 3: src = p.in[I_WUKV] + (size_t)lay * 256 * 1024; dst = (bf16*)(p.ws + OFF_WUKV + lay * SZ_WUKV); gv = p.in[I_KVNORM] + lay * 256; break;
    case 4: src = p.in[I_OWIN] + (size_t)lay * 1024 * O_IN; dst = (bf16*)(p.ws + OFF_WOIN + lay * SZ_WOIN); break;
    default: src = p.in[I_OWOUT] + (size_t)lay * 1024 * 1024; dst = (bf16*)(p.ws + OFF_WOOUT + lay * SZ_WOUT); break;
  }
  const int ktiles = K >> 6;
  const int k0 = (rem % ktiles) * 64, n0 = (rem / ktiles) * 64;
  float* t = (float*)smem;
  __syncthreads();
#pragma unroll
  for (int i = 0; i < 16; ++i) {
    int k = i * 4 + (tid >> 6), n = tid & 63;
    float v = 0.f;
    if (n0 + n < N) { v = src[(size_t)(k0 + k) * N + n0 + n]; if (gv) v *= gv[k0 + k]; }
    t[k * 65 + n] = v;
  }
  __syncthreads();
#pragma unroll
  for (int i = 0; i < 16; ++i) {
    int n = i * 4 + (tid >> 6), k = tid & 63;
    dst[(size_t)(n0 + n) * K + k0 + k] = f2bf(t[k * 65 + n]);
  }
}
constexpr int N_WTILES = 2 * (16 * 52 + 256 + 6 * 12 + 4 * 16 + 16 * 48 + 256);
constexpr int N_WEARLY = 16 * 52 + 6 * 12 + 4 * 16 + 256;

DI void prep_lruw(const Params& p, unsigned char* smem, int item, int tid) {
  tid = launder(tid);
  const int which = item & 1, m = item >> 1;
  const float* src = (which ? p.in[I_WX] : p.in[I_WA]) + (size_t)m * 4096;
  bf16* dst = (bf16*)(p.ws + OFF_LW) + (size_t)item * 4096;
  float* t = (float*)smem;
  __syncthreads();
#pragma unroll
  for (int i = 0; i < 16; ++i) { int k = i * 4 + (tid >> 6), n = tid & 63; t[k * 65 + n] = src[k * 64 + n]; }
  __syncthreads();
#pragma unroll
  for (int i = 0; i < 16; ++i) { int n = i * 4 + (tid >> 6), k = tid & 63; dst[n * 64 + k] = f2bf(t[k * 65 + n]); }
}


DI void prep_mod(const Params& p, unsigned char* smem, int item, int tid) {
  tid = launder(tid);
  const int l = item / 48, cb = item % 48;
  const int col = cb * 64 + (tid & 63), kg = tid >> 6;
  const float* w = p.in[I_MODW] + (size_t)l * 1024 * 3072;
  float* sv = (float*)smem + 512;
  __syncthreads();
#pragma unroll
  for (int i = 0; i < 4; ++i) { int k = tid + 256 * i; sv[k] = silu(p.in[I_C][k]); sv[1024 + k] = silu(p.in[I_CCTX][k]); }
  __syncthreads();
  float aL = 0.f, aC = 0.f;
#pragma unroll 16
  for (int k = kg * 256; k < kg * 256 + 256; ++k) {
    float wv = w[(size_t)k * 3072 + col];
    aL += sv[k] * wv;
    aC += sv[1024 + k] * wv;
  }
  float* t = (float*)smem;
  __syncthreads();
  t[tid] = aL; t[256 + tid] = aC;
  __syncthreads();
  if (tid < 64) {
    float b = p.in[I_MODB][l * 3072 + col];
    float sL = t[tid] + t[64 + tid] + t[128 + tid] + t[192 + tid] + b;
    float sC = t[256 + tid] + t[320 + tid] + t[384 + tid] + t[448 + tid] + b;
    float* mod = (float*)(p.ws + OFF_MOD);
    mod[(l * 2 + 0) * 3072 + col] = sL;
    mod[(l * 2 + 1) * 3072 + col] = sC;
  }
}

DI void prep_tab(const Params& p, int item, int tid) {
  tid = launder(tid);
  int e = item * 256 + tid;
  if (e < 4096) {
    int pos = e >> 4, f = e & 15;
    float inv = powf(10000.f, -(float)f / 16.f);
    float a = (float)pos * inv, s, c; sincosf(a, &s, &c);
    ((float2*)(p.ws + OFF_T64))[e] = make_float2(c, s);
  } else {
    e -= 4096;
    int pos = e >> 3, f = e & 7;
    float inv = powf(10000.f, -(float)f / 8.f);
    float a = (float)pos * inv, s, c; sincosf(a, &s, &c);
    ((float2*)(p.ws + OFF_T32))[e] = make_float2(c, s);
  }
}

DI void prep_copy(const Params& p, int item, int tid) {
  tid = launder(tid);
#pragma unroll 4
  for (int i = 0; i < 16; ++i) {
    int row = item * 16 + i;
    const float* s = row < NCTX ? p.in[I_CTX] + (size_t)row * 1024 : p.in[I_X] + (size_t)(row - NCTX) * 1024;
    ((float4*)xrow(p, row))[tid] = ((const float4*)s)[tid];
  }
}

DI void norm_rows(const Params& p, int l, int item, int tid) {
  tid = launder(tid);
  const int row = item * 4 + (tid >> 6), lane = tid & 63;
  const float* x = (l == 0) ? xrow_in(p, row) : (const float*)xrow(p, row);
  float4 v[4]; float ss = 0.f;
#pragma unroll
  for (int i = 0; i < 4; ++i) { v[i] = ((const float4*)x)[i * 64 + lane]; ss += v[i].x * v[i].x + v[i].y * v[i].y + v[i].z * v[i].z + v[i].w * v[i].w; }
  ss = wave_sum(ss);
  const float rstd = rsqrtf(ss * (1.f / 1024.f) + EPS);
  const float* mod = (const float*)(p.ws + OFF_MOD) + (l * 2 + (row < NCTX ? 1 : 0)) * 3072;
  const float* g = p.in[I_NORMG] + l * 1024;
  bf16* h = (bf16*)(p.ws + OFF_HY) + (size_t)row * 1024;
#pragma unroll
  for (int i = 0; i < 4; ++i) {
    int k = (i * 64 + lane) * 4;
    float4 gg = *(const float4*)(g + k), sh = *(const float4*)(mod + k), sc = *(const float4*)(mod + 1024 + k);
    float a = v[i].x * rstd * gg.x * (1.f + sc.x) + sh.x;
    float b = v[i].y * rstd * gg.y * (1.f + sc.y) + sh.y;
    float c = v[i].z * rstd * gg.z * (1.f + sc.z) + sh.z;
    float d = v[i].w * rstd * gg.w * (1.f + sc.w) + sh.w;
    u32x2 o = {pack2(a, b), pack2(c, d)};
    *(u32x2*)(h + k) = o;
  }
}

DI void final_rows(const Params& p, int item, int tid) {
  tid = launder(tid);
  const int row = item * 4 + (tid >> 6), lane = tid & 63;
  float* x = p.out + (size_t)row * 1024;
  float4 v[4]; float ss = 0.f;
#pragma unroll
  for (int i = 0; i < 4; ++i) { v[i] = ((const float4*)x)[i * 64 + lane]; ss += v[i].x * v[i].x + v[i].y * v[i].y + v[i].z * v[i].z + v[i].w * v[i].w; }
  ss = wave_sum(ss);
  const float rstd = rsqrtf(ss * (1.f / 1024.f) + EPS);
  const float* g = p.in[I_FINALG];
#pragma unroll
  for (int i = 0; i < 4; ++i) {
    int k = (i * 64 + lane) * 4;
    float4 gg = *(const float4*)(g + k);
    float4 o = make_float4(v[i].x * rstd * gg.x, v[i].y * rstd * gg.y, v[i].z * rstd * gg.z, v[i].w * rstd * gg.w);
    *(float4*)(x + k) = o;
  }
}

template <bool TR>
DI void gemm_k(const bf16* __restrict__ A, int lda, const bf16* __restrict__ B, int ldb, int K, unsigned char* smem,
               f32x16 (&acc)[2][2], int tid, int lane, int wm, int wn) {
  const int lr = lane & 31, lh = lane >> 5;
  u32x4 ra[4], rb[4];
#pragma unroll
  for (int i = 0; i < 4; ++i) {
    int c = tid + 256 * i, row = c >> 3, cj = c & 7;
    ra[i] = *(const u32x4*)(A + (size_t)row * lda + cj * 8);
    rb[i] = *(const u32x4*)(B + (size_t)row * ldb + cj * 8);
  }
#pragma unroll 1
  for (int k0 = 0; k0 < K; k0 += 64) {
    __syncthreads();
#pragma unroll
    for (int i = 0; i < 4; ++i) {
      int c = tid + 256 * i, row = c >> 3, cj = c & 7;
      *(u32x4*)(smem + row * 144 + cj * 16) = ra[i];
      *(u32x4*)(smem + 18432 + row * 144 + cj * 16) = rb[i];
    }
    __syncthreads();
    if (k0 + 64 < K) {
#pragma unroll
      for (int i = 0; i < 4; ++i) {
        int c = tid + 256 * i, row = c >> 3, cj = c & 7;
        ra[i] = *(const u32x4*)(A + (size_t)row * lda + k0 + 64 + cj * 8);
        rb[i] = *(const u32x4*)(B + (size_t)row * ldb + k0 + 64 + cj * 8);
      }
    }
#pragma unroll
    for (int ks = 0; ks < 4; ++ks) {
      bf16x8 af[2], bfr[2];
#pragma unroll
      for (int t = 0; t < 2; ++t) {
        af[t] = *(const bf16x8*)(smem + (wm * 64 + t * 32 + lr) * 144 + ks * 32 + lh * 16);
        bfr[t] = *(const bf16x8*)(smem + 18432 + (wn * 64 + t * 32 + lr) * 144 + ks * 32 + lh * 16);
      }
#pragma unroll
      for (int mt = 0; mt < 2; ++mt)
#pragma unroll
        for (int nt = 0; nt < 2; ++nt)
          acc[mt][nt] = TR ? MFMA(bfr[nt], af[mt], acc[mt][nt]) : MFMA(af[mt], bfr[nt], acc[mt][nt]);
    }
  }
}

enum { EP_EVEN_IN = 0, EP_UPQ, EP_UPKV, EP_ODD_IN, EP_OUT };

DI void st_tile_rm(bf16* base, size_t row_stride, int m0, int lh, const f32x16& a, float s0 = 1.f) {
#pragma unroll
  for (int i = 0; i < 16; ++i) base[(size_t)(m0 + crow(i, lh)) * row_stride] = f2bf(a[i] * s0);
}

DI void stage_val(unsigned char* wl, int row, int col, float v) { *(bf16*)(wl + row * 144 + col * 2) = f2bf(v); }
DI void flush_unit(const unsigned char* wl, int nt, int lane, bf16* base, int stride) {
#pragma unroll
  for (int j = 0; j < 4; ++j) {
    const int c = lane + 64 * j, row = c >> 2, ch = c & 3;
    const u32x4 d = *(const u32x4*)(wl + row * 144 + nt * 64 + ch * 16);
    *(u32x4*)(base + (size_t)row * stride + ch * 8) = d;
  }
}

template <int MODE>
DI void gemm_tile(const Params& p, unsigned char* smem, int layer, int mtile, int ntile, int tid) {
  tid = launder(tid);
  const int li = layer >> 1;
  const int lane = tid & 63, lr = lane & 31, lh = lane >> 5;
  const int wave = __builtin_amdgcn_readfirstlane(tid >> 6);
  const int wm = wave >> 1, wn = wave & 1;
  const int m0 = mtile * 128, n0 = ntile * 128;
  const int m0w = m0 + wm * 64, n0w = n0 + wn * 64;
  const bool is_lat = m0 >= NCTX;
  unsigned char* ws = p.ws;
  const bf16* A; const bf16* B; int lda, K;
  bool tr = false;
  if (MODE == EP_EVEN_IN) { A = (const bf16*)(ws + OFF_HY); lda = 1024; K = 1024; B = (const bf16*)(ws + OFF_WEIN + li * SZ_WEIN); tr = (n0w >= 1024 && n0w < 1536); }
  else if (MODE == EP_ODD_IN) { A = (const bf16*)(ws + OFF_HY); lda = 1024; K = 1024; B = (const bf16*)(ws + OFF_WOIN + li * SZ_WOIN); tr = (n0w >= 1024 && n0w < 1536); }
  else if (MODE == EP_UPQ) { A = (const bf16*)(ws + OFF_QL); lda = 384; K = 384; B = (const bf16*)(ws + OFF_WUQ + li * SZ_WUQ); }
  else if (MODE == EP_UPKV) { A = (const bf16*)(ws + OFF_KVL); lda = 256; K = 256; B = (const bf16*)(ws + OFF_WUKV + li * SZ_WUKV); tr = ((n0w >> 6) & 1) != 0; }
  else { A = (const bf16*)(ws + OFF_HY); lda = 1024; K = 1024; B = (const bf16*)(ws + ((layer & 1) ? OFF_WOOUT : OFF_WEOUT) + li * SZ_WOUT); }
  A += (size_t)m0 * lda; B += (size_t)n0 * K;

  float* rs = (float*)(smem + 36864);
  if (MODE == EP_UPQ || MODE == EP_UPKV) {
    __syncthreads();
    const int row = tid >> 1, half = tid & 1, hk = K >> 1;
    const bf16* ar = A + (size_t)row * lda + half * hk;
    float ss = 0.f;
    for (int k = 0; k < hk; k += 8) {
      u32x4 u = *(const u32x4*)(ar + k);
      unsigned w4[4] = {u.x, u.y, u.z, u.w};
#pragma unroll
      for (int j = 0; j < 4; ++j) { float a = __uint_as_float(w4[j] << 16), b = __uint_as_float(w4[j] & 0xffff0000u); ss += a * a + b * b; }
    }
    ss += __shfl_xor(ss, 1);
    if (half == 0) rs[row] = rsqrtf(ss / (float)K + EPS);
  }

  f32x16 acc[2][2];
#pragma unroll
  for (int a = 0; a < 2; ++a)
#pragma unroll
    for (int b = 0; b < 2; ++b)
#pragma unroll
      for (int i = 0; i < 16; ++i) acc[a][b][i] = 0.f;
  if (tr) gemm_k<true>(A, lda, B, K, K, smem, acc, tid, lane, wm, wn);
  else gemm_k<false>(A, lda, B, K, K, smem, acc, tid, lane, wm, wn);
  if (MODE == EP_EVEN_IN || MODE == EP_ODD_IN) __syncthreads();
  unsigned char* wl = smem + wave * 9216;

  if (MODE == EP_OUT) {
    const float* gm = (const float*)(ws + OFF_MOD) + (layer * 2 + (is_lat ? 0 : 1)) * 3072 + 2048;
#pragma unroll
    for (int mt = 0; mt < 2; ++mt)
#pragma unroll
      for (int nt = 0; nt < 2; ++nt) {
        const int n = n0w + nt * 32 + lr; const float g = gm[n];
#pragma unroll
        for (int i = 0; i < 16; ++i) {
          const int m = m0w + mt * 32 + crow(i, lh);
          float* x = xrow(p, m) + n;
          const float xin = (layer == 0) ? xrow_in(p, m)[n] : *x;
          *x = xin + g * acc[mt][nt][i];
        }
      }
    return;
  }
  if (MODE == EP_UPQ) {
    const float2* t32 = (const float2*)(ws + OFF_T32);
#pragma unroll
    for (int mt = 0; mt < 2; ++mt)
#pragma unroll
      for (int nt = 0; nt < 2; ++nt) {
        const int nn = n0w + nt * 32, head = nn / 96, j0 = nn % 96;
        bf16* dst = (bf16*)(ws + OFF_QM) + (size_t)head * NT * 96 + j0 + lr;
        const bool rope = (j0 == 64) && is_lat;
#pragma unroll
        for (int i = 0; i < 16; ++i) {
          const int ml = wm * 64 + mt * 32 + crow(i, lh), m = m0 + ml;
          float v = acc[mt][nt][i] * rs[ml];
          if (rope) {
            float pv = __shfl_xor(v, 16);
            int t = m - NCTX, idx = lr & 15, pos = (idx < 8) ? (t >> 6) : (t & 63);
            float2 cs = t32[pos * 8 + (idx & 7)];
            v = (lr < 16) ? (v * cs.x - pv * cs.y) : (pv * cs.y + v * cs.x);
          }
          dst[(size_t)m * 96] = f2bf(v);
        }
      }
    return;
  }
  if (MODE == EP_UPKV) {
    const int head = n0w >> 7;
    if (!tr) {
#pragma unroll
      for (int mt = 0; mt < 2; ++mt)
#pragma unroll
        for (int nt = 0; nt < 2; ++nt) {
          bf16* dst = (bf16*)(ws + OFF_KM) + (size_t)head * NT * 96 + nt * 32 + lr;
#pragma unroll
          for (int i = 0; i < 16; ++i) { const int ml = wm * 64 + mt * 32 + crow(i, lh); dst[(size_t)(m0 + ml) * 96] = f2bf(acc[mt][nt][i] * rs[ml]); }
        }
    } else {
#pragma unroll
      for (int mt = 0; mt < 2; ++mt)
#pragma unroll
        for (int nt = 0; nt < 2; ++nt) {
          const int ml = wm * 64 + mt * 32 + lr; const float r = rs[ml];
          bf16* dst = (bf16*)(ws + OFF_VMT) + (size_t)head * 64 * NT + m0 + ml;
#pragma unroll
          for (int i = 0; i < 16; ++i) dst[(size_t)(nt * 32 + crow(i, lh)) * NT] = f2bf(acc[mt][nt][i] * r);
        }
    }
    return;
  }
  if (MODE == EP_EVEN_IN) {
    if (tr) {
#pragma unroll
      for (int mt = 0; mt < 2; ++mt)
#pragma unroll
        for (int nt = 0; nt < 2; ++nt) {
          const int nb = n0w - 1024 + nt * 32, m = m0w + mt * 32 + lr;
          bf16* dst = (bf16*)(ws + OFF_VAT) + (size_t)nb * NT + m;
#pragma unroll
          for (int i = 0; i < 16; ++i) dst[(size_t)crow(i, lh) * NT] = f2bf(acc[mt][nt][i]);
        }
      return;
    }
    const float2* t32 = (const float2*)(ws + OFF_T32);
#pragma unroll
    for (int mt = 0; mt < 2; ++mt)
#pragma unroll
      for (int nt = 0; nt < 2; ++nt) {
        const int nn = n0w + nt * 32;
        const bool krope = (nn >= 2688 && nn < 2720);
#pragma unroll
        for (int i = 0; i < 16; ++i) {
          const int ml = mt * 32 + crow(i, lh), m = m0w + ml;
          float v = acc[mt][nt][i];
          if (krope && is_lat) {
            float pv = __shfl_xor(v, 16);
            int t = m - NCTX, idx = lr & 15, pos = (idx < 8) ? (t >> 6) : (t & 63);
            float2 cs = t32[pos * 8 + (idx & 7)];
            v = (lr < 16) ? (v * cs.x - pv * cs.y) : (pv * cs.y + v * cs.x);
          }
          stage_val(wl, ml, nt * 32 + lr, v);
        }
      }
#pragma unroll
    for (int nt = 0; nt < 2; ++nt) {
      const int nn = n0w + nt * 32;
      bf16* base = nullptr; int stride = 0;
      if (nn < 512) { base = (bf16*)(ws + OFF_QA) + (size_t)(nn >> 6) * NT * 64 + (nn & 63); stride = 64; }
      else if (nn < 1024) { base = (bf16*)(ws + OFF_KA) + (size_t)((nn - 512) >> 6) * NT * 64 + (nn & 63); stride = 64; }
      else if (nn < 2048) { base = (bf16*)(ws + OFF_G) + (nn - 1536); stride = 1024; }
      else if (nn < 2432) { base = (bf16*)(ws + OFF_QL) + (nn - 2048); stride = 384; }
      else if (nn < 2688) { base = (bf16*)(ws + OFF_KVL) + (nn - 2432); stride = 256; }
      else if (nn < 2720) { base = (bf16*)(ws + OFF_KM) + 64; stride = 96; }
      else if (nn < E_IN) { base = (bf16*)(ws + OFF_G) + 512 + (nn - 2720); stride = 1024; }
      if (!base) continue;
      base += (size_t)m0w * stride;
      flush_unit(wl, nt, lane, base, stride);
      if (nn >= 2688 && nn < 2720) {
#pragma unroll 1
        for (int hh = 1; hh < 8; ++hh) flush_unit(wl, nt, lane, base + (size_t)hh * NT * 96, stride);
      }
    }
    return;
  }
  if (MODE == EP_ODD_IN) {
    if (tr) {
#pragma unroll
      for (int mt = 0; mt < 2; ++mt)
#pragma unroll
        for (int nt = 0; nt < 2; ++nt) {
          const int nb = n0w - 1024 + nt * 32, m = m0w + mt * 32 + lr;
          bf16* dst = (bf16*)(ws + OFF_VAT) + (size_t)nb * NT + m;
#pragma unroll
          for (int i = 0; i < 16; ++i) dst[(size_t)crow(i, lh) * NT] = f2bf(acc[mt][nt][i]);
        }
      return;
    }
    if (n0w < 1024) {
      const float2* t64 = (const float2*)(ws + OFF_T64);
      const int hw = (n0w & 511) >> 6;
      bf16* base = (bf16*)(ws + (n0w < 512 ? OFF_QA : OFF_KA)) + (size_t)hw * NT * 64;
#pragma unroll
      for (int mt = 0; mt < 2; ++mt) {
#pragma unroll
        for (int i = 0; i < 16; ++i) {
          const int m = m0w + mt * 32 + crow(i, lh);
          float x1 = acc[mt][0][i], x2 = acc[mt][1][i];
          if (is_lat) {
            int t = m - NCTX, pos = (lr < 16) ? (t >> 6) : (t & 63);
            float2 cs = t64[pos * 16 + (lr & 15)];
            float y1 = x1 * cs.x - x2 * cs.y, y2 = x1 * cs.y + x2 * cs.x;
            x1 = y1; x2 = y2;
          }
          stage_val(wl, mt * 32 + crow(i, lh), lr, x1);
          stage_val(wl, mt * 32 + crow(i, lh), 32 + lr, x2);
        }
      }
      flush_unit(wl, 0, lane, base + (size_t)m0w * 64, 64);
      flush_unit(wl, 1, lane, base + (size_t)m0w * 64 + 32, 64);
      return;
    }
#pragma unroll
    for (int mt = 0; mt < 2; ++mt)
#pragma unroll
      for (int nt = 0; nt < 2; ++nt) {
#pragma unroll
        for (int i = 0; i < 16; ++i) stage_val(wl, mt * 32 + crow(i, lh), nt * 32 + lr, acc[mt][nt][i]);
      }
#pragma unroll
    for (int nt = 0; nt < 2; ++nt) {
      const int nn = n0w + nt * 32;
      bf16* base; int stride;
      if (nn < 2048) { base = (bf16*)(ws + OFF_G) + (nn - 1536); stride = 1024; }
      else if (nn < 2560) { base = (bf16*)(ws + OFF_QL) + (nn - 2048); stride = 512; }
      else { base = (bf16*)(ws + OFF_G) + 512 + (nn - 2560); stride = 1024; }
      flush_unit(wl, nt, lane, base + (size_t)m0w * stride, stride);
    }
    return;
  }
}

DI float xmax32(float x) { auto r = __builtin_amdgcn_permlane32_swap(__float_as_uint(x), __float_as_uint(x), false, false); return fmaxf(__uint_as_float(r[0]), __uint_as_float(r[1])); }
DI float xsum32(float x) { auto r = __builtin_amdgcn_permlane32_swap(__float_as_uint(x), __float_as_uint(x), false, false); return __uint_as_float(r[0]) + __uint_as_float(r[1]); }
template <int DQK, int DV, int NS, int MODE, int NQ>
DI void attn_item(const Params& p, unsigned char* smem, int layer, int qb, int head, int tid) {
  tid = launder(tid);
  constexpr int KS = DQK * 2 + 16;
  constexpr int VS = 136;
  constexpr int KCH = DQK / 8;
  constexpr int NKC = 64 * KCH / 256;
  constexpr int NVC = DV * 8 / 256;
  constexpr int NDT = DV / 32;
  constexpr int NKS = DQK / 16;
  constexpr int K_BYTES = 64 * KS;
  unsigned char* ws = p.ws;
  const int li = layer >> 1;
  const int lane = tid & 63, lr = lane & 31, lh = lane >> 5;
  const int wave = __builtin_amdgcn_readfirstlane(tid >> 6);
  const bool qctx = qb < 2;

  const bf16* Qp[NS]; const bf16* Kp[NS]; const bf16* VT;
  float c;
  if (MODE == 0) { Qp[0] = (const bf16*)(ws + OFF_QM) + (size_t)head * NT * 96; Kp[0] = (const bf16*)(ws + OFF_KM) + (size_t)head * NT * 96;
                   VT = (const bf16*)(ws + OFF_VMT) + (size_t)head * 64 * NT; c = 0.10206207261596577f * LOG2E; }
  else if (MODE == 1) { Qp[0] = (const bf16*)(ws + OFF_QA) + (size_t)head * NT * 64; Kp[0] = (const bf16*)(ws + OFF_KA) + (size_t)head * NT * 64;
                   VT = (const bf16*)(ws + OFF_VAT) + (size_t)head * 64 * NT; c = 0.125f * LOG2E; }
  else {
#pragma unroll
    for (int s = 0; s < NS; ++s) { Qp[s] = (const bf16*)(ws + OFF_QA) + (size_t)(head * 2 + s) * NT * 64; Kp[s] = (const bf16*)(ws + OFF_KA) + (size_t)(head * 2 + s) * NT * 64; }
    VT = (const bf16*)(ws + OFF_VAT) + (size_t)head * 128 * NT; c = 0.125f * LOG2E;
  }

  int ntiles, kr_lo = 0, r_w = 0, r0w = 0, qc = 0, c0 = 0;
  if (qctx) ntiles = 4;
  else if (MODE == 1) {
    const int lb = qb - 2, ra_ = 2 * lb, rb_ = 2 * lb + 1;
    int r0a = min(max(ra_ - 4, 0), 248), r0b = min(max(rb_ - 4, 0), 248);
    kr_lo = r0a; ntiles = 4 + (r0b + 8 - r0a);
    r_w = 2 * lb + (wave >> 1); r0w = min(max(r_w - 4, 0), 248);
    qc = (wave & 1) * 32 + lr; c0 = min(max(qc - 8, 0), 48);
  } else ntiles = NT / 64;

  float* rpb = (float*)(smem + NS * K_BYTES + DV * VS);
  if (MODE == 1) {
    __syncthreads();
    const float* src = p.in[I_RPB] + (size_t)(li * 8 + head) * 465;
    for (int i = tid; i < 465; i += 256) rpb[i] = src[i] * LOG2E;
  }

  int tq[NQ];
#pragma unroll
  for (int n = 0; n < NQ; ++n) tq[n] = (qb + n) * 128 + wave * 32 + lr;
  bf16x8 qf[NQ][NS][NKS];
#pragma unroll
  for (int n = 0; n < NQ; ++n)
#pragma unroll
    for (int s = 0; s < NS; ++s)
#pragma unroll
      for (int ks = 0; ks < NKS; ++ks) qf[n][s][ks] = *(const bf16x8*)(Qp[s] + (size_t)tq[n] * DQK + ks * 16 + lh * 8);

  f32x16 O[NQ][NS][NDT];
#pragma unroll
  for (int n = 0; n < NQ; ++n)
#pragma unroll
    for (int s = 0; s < NS; ++s)
#pragma unroll
      for (int d = 0; d < NDT; ++d)
#pragma unroll
        for (int i = 0; i < 16; ++i) O[n][s][d][i] = 0.f;
  float mrun[NQ][NS], lrun[NQ][NS];
#pragma unroll
  for (int n = 0; n < NQ; ++n)
#pragma unroll
    for (int s = 0; s < NS; ++s) { mrun[n][s] = -1e30f; lrun[n][s] = 0.f; }

  constexpr bool PF = (MODE != 2);
  u32x4 rk[NS][NKC], rv[NVC];
  auto tile_tok = [&](int it) -> int { return (MODE == 1 && !qctx && it >= 4) ? (NCTX + (kr_lo + it - 4) * 64) : it * 64; };
  auto gload = [&](int it) {
    const int t0 = tile_tok(it);
#pragma unroll
    for (int s = 0; s < NS; ++s)
#pragma unroll
      for (int i = 0; i < NKC; ++i) { int cidx = tid + 256 * i, row = cidx / KCH, cj = cidx % KCH; rk[s][i] = *(const u32x4*)(Kp[s] + (size_t)(t0 + row) * DQK + cj * 8); }
#pragma unroll
    for (int i = 0; i < NVC; ++i) { int cidx = tid + 256 * i, row = cidx >> 3, cj = cidx & 7; rv[i] = *(const u32x4*)(VT + (size_t)row * NT + t0 + cj * 8); }
  };
  if (PF) gload(0);

#pragma unroll 1
  for (int it = 0; it < ntiles; ++it) {
    __syncthreads();
    if (!PF) gload(it);
#pragma unroll
    for (int s = 0; s < NS; ++s)
#pragma unroll
      for (int i = 0; i < NKC; ++i) { int cidx = tid + 256 * i, row = cidx / KCH, cj = cidx % KCH; *(u32x4*)(smem + s * K_BYTES + row * KS + cj * 16) = rk[s][i]; }
#pragma unroll
    for (int i = 0; i < NVC; ++i) { int cidx = tid + 256 * i, row = cidx >> 3, cj = cidx & 7;
      u32x2* d = (u32x2*)(smem + NS * K_BYTES + row * VS + cj * 16); u32x2 d0 = {rv[i].x, rv[i].y}, d1 = {rv[i].z, rv[i].w}; d[0] = d0; d[1] = d1; }
    __syncthreads();
    if (PF && it + 1 < ntiles) gload(it + 1);

    bool active = true; int kr = 0;
    if (MODE == 1 && !qctx && it >= 4) { kr = kr_lo + it - 4; active = (kr >= r0w) && (kr < r0w + 8); }
    if (!active) continue;

#pragma unroll(MODE == 2 ? 1 : 2)
    for (int sub = 0; sub < 2; ++sub) {
      bf16x8 P[NQ][NS][2];
#pragma unroll
      for (int s = 0; s < NS; ++s) {
        f32x16 S[NQ];
#pragma unroll
        for (int n = 0; n < NQ; ++n)
#pragma unroll
          for (int i = 0; i < 16; ++i) S[n][i] = 0.f;
#pragma unroll
        for (int ks = 0; ks < NKS; ++ks) {
          bf16x8 kf = *(const bf16x8*)(smem + s * K_BYTES + (sub * 32 + lr) * KS + ks * 32 + lh * 16);
#pragma unroll
          for (int n = 0; n < NQ; ++n) S[n] = MFMA(kf, qf[n][s][ks], S[n]);
        }
#pragma unroll
        for (int n = 0; n < NQ; ++n) {
          float cc = c;
          if (MODE == 1) {
            cc = 1.f;
            if (!qctx && it >= 4) {
              const float* brow = rpb + (kr - r_w + 7) * 31;
#pragma unroll
              for (int i = 0; i < 16; ++i) {
                const int kc = sub * 32 + crow(i, lh);
                const bool valid = (kc >= c0) && (kc < c0 + 16);
                const int bi = min(max(kc - qc + 15, 0), 30);
                S[n][i] = valid ? (S[n][i] * c + brow[bi]) : -1e30f;
              }
            } else {
#pragma unroll
              for (int i = 0; i < 16; ++i) S[n][i] = S[n][i] * c;
            }
          }
          float mx = S[n][0];
#pragma unroll
          for (int i = 1; i < 16; ++i) mx = fmaxf(mx, S[n][i]);
          mx = xmax32(mx);
          const float mnew = fmaxf(mrun[n][s], mx);
          if (__any(mnew > mrun[n][s])) {
            const float alpha = __builtin_amdgcn_exp2f((mrun[n][s] - mnew) * cc);
            lrun[n][s] *= alpha;
#pragma unroll
            for (int d = 0; d < NDT; ++d)
#pragma unroll
              for (int i = 0; i < 16; ++i) O[n][s][d][i] *= alpha;
            mrun[n][s] = mnew;
          }
          const float mc = mrun[n][s] * cc;
          float ls0 = 0.f, ls1 = 0.f;
#pragma unroll
          for (int i = 0; i < 16; i += 2) { S[n][i] = __builtin_amdgcn_exp2f(S[n][i] * cc - mc); S[n][i + 1] = __builtin_amdgcn_exp2f(S[n][i + 1] * cc - mc); ls0 += S[n][i]; ls1 += S[n][i + 1]; }
          lrun[n][s] += ls0 + ls1;
#pragma unroll
          for (int s2 = 0; s2 < 2; ++s2) {
            u32x4 u = {pack2(S[n][8 * s2 + 0], S[n][8 * s2 + 1]), pack2(S[n][8 * s2 + 2], S[n][8 * s2 + 3]),
                       pack2(S[n][8 * s2 + 4], S[n][8 * s2 + 5]), pack2(S[n][8 * s2 + 6], S[n][8 * s2 + 7])};
            P[n][s][s2] = __builtin_bit_cast(bf16x8, u);
          }
        }
      }
#pragma unroll
      for (int d = 0; d < NDT; ++d)
#pragma unroll
        for (int s2 = 0; s2 < 2; ++s2) {
          const unsigned char* vp = smem + NS * K_BYTES + (d * 32 + lr) * VS + (sub * 32 + 16 * s2 + 4 * lh) * 2;
          u32x2 lo = *(const u32x2*)vp, hi = *(const u32x2*)(vp + 16);
          u32x4 u = {lo.x, lo.y, hi.x, hi.y};
          bf16x8 vf = __builtin_bit_cast(bf16x8, u);
#pragma unroll
          for (int n = 0; n < NQ; ++n)
#pragma unroll
            for (int s = 0; s < NS; ++s) O[n][s][d] = MFMA(vf, P[n][s][s2], O[n][s][d]);
        }
    }
  }

#pragma unroll
  for (int n = 0; n < NQ; ++n) {
    float inv[NS];
#pragma unroll
    for (int s = 0; s < NS; ++s) inv[s] = 1.f / xsum32(lrun[n][s]);
    bf16* yrow = (bf16*)(ws + OFF_HY) + (size_t)tq[n] * 1024;
    const bf16* grow = (const bf16*)(ws + OFF_G) + (size_t)tq[n] * 1024;
    if (MODE != 2) {
      const int col0 = (MODE == 0 ? 512 : 0) + head * 64;
#pragma unroll
      for (int d = 0; d < NDT; ++d)
#pragma unroll
        for (int g4 = 0; g4 < 4; ++g4) {
          const int col = col0 + d * 32 + 8 * g4 + 4 * lh;
          u32x2 gu = *(const u32x2*)(grow + col);
          float g0 = __uint_as_float(gu.x << 16), g1 = __uint_as_float(gu.x & 0xffff0000u), g2 = __uint_as_float(gu.y << 16), g3 = __uint_as_float(gu.y & 0xffff0000u);
          float y0 = O[n][0][d][4 * g4 + 0] * inv[0] * silu(g0), y1 = O[n][0][d][4 * g4 + 1] * inv[0] * silu(g1);
          float y2 = O[n][0][d][4 * g4 + 2] * inv[0] * silu(g2), y3 = O[n][0][d][4 * g4 + 3] * inv[0] * silu(g3);
          { u32x2 yo = {pack2(y0, y1), pack2(y2, y3)}; *(u32x2*)(yrow + col) = yo; }
        }
    } else {
      const float lam_init = __uint_as_float((unsigned)__builtin_amdgcn_readfirstlane((layer == 1) ? 0x3eb60549 : 0x3f0e59d5));
      float v1 = p.in[I_LQ1][li * 64 + lane] * p.in[I_LK1][li * 64 + lane];
      float v2 = p.in[I_LQ2][li * 64 + lane] * p.in[I_LK2][li * 64 + lane];
      v1 = wave_sum(v1); v2 = wave_sum(v2);
      const float lam = __expf(v1) - __expf(v2) + lam_init;
      float ss = 0.f;
#pragma unroll
      for (int d = 0; d < NDT; ++d)
#pragma unroll
        for (int i = 0; i < 16; ++i) { float o = O[n][0][d][i] * inv[0] - lam * (O[n][NS - 1][d][i] * inv[NS - 1]); O[n][0][d][i] = o; ss += o * o; }
      ss = xsum32(ss);
      const float rstd = rsqrtf(ss * (1.f / 128.f) + EPS) * (1.f - lam_init);
      const float* sub = p.in[I_SUBLN] + li * 128;
      const int col0 = head * 128;
#pragma unroll
      for (int d = 0; d < NDT; ++d)
#pragma unroll
        for (int g4 = 0; g4 < 4; ++g4) {
          const int dd = d * 32 + 8 * g4 + 4 * lh, col = col0 + dd;
          u32x2 gu = *(const u32x2*)(grow + col);
          float g0 = __uint_as_float(gu.x << 16), g1 = __uint_as_float(gu.x & 0xffff0000u), g2 = __uint_as_float(gu.y << 16), g3 = __uint_as_float(gu.y & 0xffff0000u);
          float4 sl = *(const float4*)(sub + dd);
          float y0 = O[n][0][d][4 * g4 + 0] * rstd * sl.x * silu(g0), y1 = O[n][0][d][4 * g4 + 1] * rstd * sl.y * silu(g1);
          float y2 = O[n][0][d][4 * g4 + 2] * rstd * sl.z * silu(g2), y3 = O[n][0][d][4 * g4 + 3] * rstd * sl.w * silu(g3);
          { u32x2 yo = {pack2(y0, y1), pack2(y2, y3)}; *(u32x2*)(yrow + col) = yo; }
        }
    }
  }
}

template <bool PASS2>
DI void lru_item(const Params& p, unsigned char* smem, int layer, int chunk, int g, int tid) {
  tid = launder(tid);
  const int oi = layer >> 1;
  unsigned char* ws = p.ws;
  float* us = (float*)smem;
  unsigned char* ubf = smem + 16384;
  float2* ab = (float2*)(smem + 25600);
  float2* seg = (float2*)(smem + 58368);
  float2* seg2 = seg + 256;
  const int j = tid & 63, tg = tid >> 6, ch = g * 64 + j;
  const int t0 = chunk * 64;
  const int seq_lo = chunk < 4 ? 0 : NCTX, seq_hi = chunk < 4 ? NCTX : NT;
  const bf16* lx = (const bf16*)(ws + OFF_QL);
  __syncthreads();
  if (PASS2) {
    const float2* carp = (const float2*)(ws + OFF_CAR);
#pragma unroll
    for (int d = 0; d < 2; ++d) {
      const int npre = (d == 0) ? chunk : (chunk < 4 ? 3 - chunk : 4 + (NCHUNK - 1 - chunk));
      const int i0 = (npre * tg) >> 2, i1 = (npre * (tg + 1)) >> 2;
      float2 cv[65];
#pragma unroll
      for (int q = 0; q < 65; ++q) {
        const int idx = i0 + q;
        const int cc = (d == 0) ? idx : (idx < 4 ? 3 - idx : NCHUNK + 3 - idx);
        cv[q] = make_float2(1.f, 0.f);
        if (idx < i1) cv[q] = carp[(size_t)(cc * 2 + d) * 512 + ch];
      }
      float A = 1.f, B = 0.f;
#pragma unroll
      for (int q = 0; q < 65; ++q) { B = cv[q].x * B + cv[q].y; A *= cv[q].x; }
      seg2[(d * 4 + tg) * 64 + j] = make_float2(A, B);
    }
  }
  {
    const float* cw = p.in[I_CONVW] + (size_t)oi * 4 * 512;
    const float w0 = cw[ch], w1 = cw[512 + ch], w2 = cw[1024 + ch], w3 = cw[1536 + ch], cb = p.in[I_CONVB][oi * 512 + ch];
    float xv[19];
#pragma unroll
    for (int i = 0; i < 19; ++i) { int t = t0 + tg * 16 - 2 + i; xv[i] = (t >= seq_lo && t < seq_hi) ? bf2f(lx[(size_t)t * 512 + ch]) : 0.f; }
#pragma unroll
    for (int tt = 0; tt < 16; ++tt) {
      const float uv = cb + xv[tt] * w0 + xv[tt + 1] * w1 + xv[tt + 2] * w2 + xv[tt + 3] * w3;
      us[(tg * 16 + tt) * 64 + j] = uv;
      *(bf16*)(ubf + (tg * 16 + tt) * 144 + j * 2) = f2bf(uv);
    }
  }
  float hs[16];
#pragma unroll
  for (int i = 0; i < 16; ++i) hs[i] = 0.f;
  float2* car = (float2*)(ws + OFF_CAR);

#pragma unroll 1
  for (int d = 0; d < 2; ++d) {
    __syncthreads();
    {
      const int wave = __builtin_amdgcn_readfirstlane(tid >> 6);
      const int lane = tid & 63, lr = lane & 31, lh = lane >> 5;
      const int mt = wave >> 1, nt = wave & 1;
      const bf16* wt = (const bf16*)(ws + OFF_LW) + (size_t)(((oi * 2 + d) * 8 + g) * 2) * 4096 + (nt * 32 + lr) * 64 + lh * 8;
      f32x16 ca, cx;
#pragma unroll
      for (int i = 0; i < 16; ++i) { ca[i] = 0.f; cx[i] = 0.f; }
#pragma unroll
      for (int ks = 0; ks < 4; ++ks) {
        const bf16x8 af = *(const bf16x8*)(ubf + (mt * 32 + lr) * 144 + ks * 32 + lh * 16);
        const bf16x8 ba_ = *(const bf16x8*)(wt + ks * 16);
        const bf16x8 bx_ = *(const bf16x8*)(wt + 4096 + ks * 16);
        ca = MFMA(af, ba_, ca);
        cx = MFMA(af, bx_, cx);
      }
      const int cj = nt * 32 + lr, chj = g * 64 + cj;
      const float ba = p.in[I_BA][(oi * 2 + d) * 512 + chj], bx = p.in[I_BX][(oi * 2 + d) * 512 + chj];
      const float sp = log1pf(__expf(-p.in[I_LAMBDA][(oi * 2 + d) * 512 + chj]));
#pragma unroll
      for (int i = 0; i < 16; ++i) {
        const int t = mt * 32 + crow(i, lh);
        const float r = sigm(ca[i] + ba), ig = sigm(cx[i] + bx);
        const float a = __expf(-8.f * r * sp);
        const float b = __builtin_amdgcn_sqrtf(fmaxf(1.f - a * a, 0.f)) * (ig * us[t * 64 + cj]);
        ab[t * 64 + cj] = make_float2(a, b);
      }
    }
    __syncthreads();
    float ar[16], ai[16];
    float Ap = 1.f, Bp = 0.f;
#pragma unroll
    for (int q = 0; q < 16; ++q) {
      const int tt = d ? 15 - q : q;
      const float2 v = ab[(tg * 16 + tt) * 64 + j];
      ar[tt] = v.x; ai[tt] = v.y;
      Bp = v.x * Bp + v.y; Ap *= v.x;
    }
    seg[tg * 64 + j] = make_float2(Ap, Bp);
    __syncthreads();
    if (!PASS2) {
      if (tg == 0) {
        float A = 1.f, B = 0.f;
#pragma unroll
        for (int q = 0; q < 4; ++q) { float2 sg = seg[(d ? 3 - q : q) * 64 + j]; B = sg.x * B + sg.y; A *= sg.x; }
        car[(size_t)(chunk * 2 + d) * 512 + ch] = make_float2(A, B);
      }
    } else {
      float h = 0.f;
#pragma unroll
      for (int q = 0; q < 4; ++q) { float2 sg = seg2[(d * 4 + q) * 64 + j]; h = sg.x * h + sg.y; }
      if (d == 0) {
        for (int q = 0; q < tg; ++q) { float2 sg = seg[q * 64 + j]; h = sg.x * h + sg.y; }
#pragma unroll
        for (int tt = 0; tt < 16; ++tt) { h = ar[tt] * h + ai[tt]; hs[tt] += h; }
      } else {
        for (int q = 3; q > tg; --q) { float2 sg = seg[q * 64 + j]; h = sg.x * h + sg.y; }
#pragma unroll
        for (int tt = 15; tt >= 0; --tt) { h = ar[tt] * h + ai[tt]; hs[tt] += h; }
      }
    }
  }
  if (PASS2) {
    const bf16* G = (const bf16*)(ws + OFF_G);
    bf16* Y = (bf16*)(ws + OFF_HY);
#pragma unroll
    for (int tt = 0; tt < 16; ++tt) {
      const size_t o = (size_t)(t0 + tg * 16 + tt) * 1024 + 512 + ch;
      Y[o] = f2bf(hs[tt] * silu(bf2f(G[o])));
    }
  }
}


DI void grid_barrier(unsigned* bar, unsigned k, unsigned nb) {
  asm volatile("s_waitcnt vmcnt(0) lgkmcnt(0)" ::: "memory");
  __syncthreads();
  if (threadIdx.x == 0) {
    __builtin_amdgcn_fence(__ATOMIC_RELEASE, "agent");
    asm volatile("s_waitcnt vmcnt(0)" ::: "memory");
    const unsigned g = blockIdx.x & 7u;
    const unsigned ngroups = nb < 8u ? nb : 8u;
    const unsigned gsize = (nb - g + 7u) >> 3;
    const unsigned old = __hip_atomic_fetch_add(bar + 128 + 32 * g, 1u, __ATOMIC_RELAXED, __HIP_MEMORY_SCOPE_AGENT);
    if (old == gsize * k - 1u) {
      const unsigned old2 = __hip_atomic_fetch_add(bar, 1u, __ATOMIC_RELAXED, __HIP_MEMORY_SCOPE_AGENT);
      if (old2 == ngroups * k - 1u) __hip_atomic_store(bar + 64, k, __ATOMIC_RELAXED, __HIP_MEMORY_SCOPE_AGENT);
    }
    while (__hip_atomic_load(bar + 64, __ATOMIC_RELAXED, __HIP_MEMORY_SCOPE_AGENT) < k) __builtin_amdgcn_s_sleep(1);
    __builtin_amdgcn_fence(__ATOMIC_ACQUIRE, "agent");
    asm volatile("s_waitcnt vmcnt(0)" ::: "memory");
  }
  __syncthreads();
}

DI int grab_item(unsigned* ctr, int base, int wv, int* slot) {
  const int t = launder(wv);
  __syncthreads();
  if (t == 0) *slot = base + (int)__hip_atomic_fetch_add(ctr, 1u, __ATOMIC_RELAXED, __HIP_MEMORY_SCOPE_AGENT);
  __syncthreads();
  return __builtin_amdgcn_readfirstlane(*slot);
}

constexpr int N_PHASES = 22;

__global__ void __launch_bounds__(256, 2) mega(Params p, int ph_lo, int ph_hi) {
  __shared__ __attribute__((aligned(16))) unsigned char smem[LDS_BYTES];
  __shared__ int s_item;
  const int tid = __builtin_amdgcn_readfirstlane(threadIdx.x >> 6);
  const int nb = gridDim.x;
  if ((int)blockIdx.x < (nb >> 1)) __builtin_amdgcn_s_setprio(1);
#pragma unroll 1
  for (int ph = ph_lo; ph < ph_hi; ++ph) {
    if (ph > ph_lo) {
      if (ph_hi < 0) cg::this_grid().sync();
      grid_barrier((unsigned*)(p.ws + OFF_BAR), (unsigned)(ph - ph_lo), (unsigned)nb);
    }
    if (ph == 0) {
      constexpr int n_items = 192 + 64 + 24 + N_WEARLY;
      unsigned* ctr0 = (unsigned*)(p.ws + OFF_BAR) + 32;
      for (int it = blockIdx.x; it < n_items; it = grab_item(ctr0, nb, tid, &s_item)) {
        if (it < 192) prep_mod(p, smem, it, tid);
        else if (it < 256) prep_lruw(p, smem, it - 192, tid);
        else if (it < 280) prep_tab(p, it - 256, tid);
        else prep_wtile(p, smem, it - 280, tid);
      }
      continue;
    }
    if (ph == N_PHASES - 1) {
      for (int it = blockIdx.x; it < 4096; it += nb) final_rows(p, it, tid);
      continue;
    }
    const int layer = (ph - 1) / 5, sub = (ph - 1) % 5;
    const bool odd = layer & 1;
    unsigned* ctr = (unsigned*)(p.ws + OFF_BAR) + 32 + ph;
#define NEXT_ITEM grab_item(ctr, nb, tid, &s_item)
    if (sub == 0) {
      for (int it = blockIdx.x; it < NT / 4; it += nb) norm_rows(p, layer, it, tid);
    } else if (sub == 1) {
      if (!odd) { for (int it = blockIdx.x; it < 130 * 26; it = NEXT_ITEM) gemm_tile<EP_EVEN_IN>(p, smem, layer, it / 26, it % 26, tid); }
      else { for (int it = blockIdx.x; it < 130 * 24; it = NEXT_ITEM) gemm_tile<EP_ODD_IN>(p, smem, layer, it / 24, it % 24, tid); }
    } else if (sub == 2) {
      if (!odd) {
        for (int it = blockIdx.x; it < 130 * 14; it = NEXT_ITEM) {
          const int mt = it / 14, nt = it % 14;
          if (nt < 6) gemm_tile<EP_UPQ>(p, smem, layer, mt, nt, tid);
          else gemm_tile<EP_UPKV>(p, smem, layer, mt, nt - 6, tid);
        }
      } else {
        for (int it = blockIdx.x; it < NCHUNK * 8; it = NEXT_ITEM) lru_item<false>(p, smem, layer, it >> 3, it & 7, tid);
      }
    } else if (sub == 3) {
      if (!odd) {
        const int n_fill = (layer == 0) ? (N_WTILES - N_WEARLY) : 0;
        for (int it = blockIdx.x; it < 520 + 1040 + n_fill; it = NEXT_ITEM) {
          if (it >= 1560) { prep_wtile(p, smem, N_WEARLY + it - 1560, tid); continue; }
          if (it < 520) {
            const int head = it & 7, pi = it >> 3;
            const int qb = pi < 64 ? 2 + 2 * pi : 0;
            attn_item<96, 64, 1, 0, 2>(p, smem, layer, qb, head, tid);
          } else {
            const int idx = it - 520;
            const int head = idx & 7, qbi = idx >> 3;
            const int qb = qbi < 128 ? qbi + 2 : qbi - 128;
            attn_item<64, 64, 1, 1, 1>(p, smem, layer, qb, head, tid);
          }
        }
      } else {
        for (int it = blockIdx.x; it < 520 + NCHUNK * 8; it = NEXT_ITEM) {
          if (it < 520) {
            const int head = it & 3, qbi = it >> 2;
            const int qb = qbi < 128 ? qbi + 2 : qbi - 128;
#ifndef NO_DIFF
            attn_item<64, 128, 2, 2, 1>(p, smem, layer, qb, head, tid);
#endif
          } else {
            const int k = it - 520;
#ifndef NO_LRU
            lru_item<true>(p, smem, layer, k >> 3, k & 7, tid);
#endif
          }
        }
      }
    } else {
      const int skip = (layer == 3) ? 16 : 0;
      for (int it = blockIdx.x; it < 130 * 8 - skip; it = NEXT_ITEM) gemm_tile<EP_OUT>(p, smem, layer, (it + skip) >> 3, (it + skip) & 7, tid);
    }
  }
}

extern "C" void kernel_launch(void* const* d_in, const int* in_sizes, int n_in, void* d_out, int out_size, void* d_ws, size_t ws_size,
                              hipStream_t stream) {
  static int grid_blocks = 0;
  if (!grid_blocks) {
    int dev = 0, cus = 0, per_cu = 0;
    hipGetDevice(&dev);
    hipDeviceGetAttribute(&cus, hipDeviceAttributeMultiprocessorCount, dev);
    hipOccupancyMaxActiveBlocksPerMultiprocessor(&per_cu, mega, 256, 0);
    if (per_cu < 1) per_cu = 1;
    if (per_cu > 2) per_cu = 2;
    grid_blocks = cus * per_cu;
    if (ws_size < WS_END) fprintf(stderr, "kernel_launch: workspace too small (%zu < %zu)\n", ws_size, (size_t)WS_END);
  }
  Params p{};
  for (int i = 0; i < 29; ++i) p.in[i] = (const float*)d_in[i];
  p.out = (float*)d_out; p.ws = (unsigned char*)d_ws;
#if COOP
  hipMemsetAsync((unsigned char*)d_ws + OFF_BAR, 0, 2048, stream);
  int lo = 0, hi = N_PHASES;
  void* args[] = {&p, &lo, &hi};
  hipError_t e = hipLaunchCooperativeKernel((void*)mega, dim3(grid_blocks), dim3(256), args, 0, stream);
  if (e != hipSuccess) fprintf(stderr, "cooperative launch failed: %s (grid %d)\n", hipGetErrorString(e), grid_blocks);
#else
  for (int ph = 0; ph < N_PHASES; ++ph) hipLaunchKernelGGL(mega, dim3(grid_blocks), dim3(256), 0, stream, p, ph, ph + 1);
#endif
}
```
